# Optimizing an MI355X kernel written in HIP

```python
import jax, jax.numpy as jnp
from jax import lax
import numpy as np

D_MODEL = 1024
BATCH = 16
SEQ = 4096
DEPTH = 4

CHUNK = 64
NORM_EPS = 1e-6
A_WIDTH = D_MODEL // 2
A_EXPAND = 128
A_HEADS = A_WIDTH // A_EXPAND
A_DV = A_WIDTH // A_HEADS
B_HEADS = 4
B_DK = 64
B_DV = 2 * B_DK
B_QK = B_HEADS * B_DK
B_V = B_HEADS * B_DV
ROPE_BASE = 10000.0
C_HEADS = 4
C_DK = 64
C_DV = 128
C_QK = C_HEADS * C_DK
C_V = C_HEADS * C_DV
GK_RANK = 16
GK_NORMALIZER = 16.0
N_BRANCHES = 3
SPLIT_SIZES = (A_WIDTH, A_WIDTH, A_WIDTH, A_WIDTH,
               B_QK, B_QK, B_V, B_V,
               C_QK, C_QK, C_V, C_V, GK_RANK,
               N_BRANCHES * D_MODEL)
PROJ_WIDTH = int(sum(SPLIT_SIZES))
SPLIT_POINTS = tuple(int(s) for s in np.cumsum(SPLIT_SIZES)[:-1])
FFN_HIDDEN = ((8 * D_MODEL + 3 * 256 - 1) // (3 * 256)) * 256

kernel_name = "hybrid_hgrn2_retnet_gla_gated_trunk"


def rmsnorm(x, w, eps=NORM_EPS):
    xf = x.astype(jnp.float32)
    y = xf * lax.rsqrt(jnp.mean(xf * xf, axis=-1, keepdims=True) + eps)
    return (y * w.astype(jnp.float32)).astype(x.dtype)


def head_groupnorm(o, eps=NORM_EPS):
    of = o.astype(jnp.float32)
    mu = jnp.mean(of, axis=-1, keepdims=True)
    var = jnp.mean(jnp.square(of - mu), axis=-1, keepdims=True)
    return ((of - mu) * lax.rsqrt(var + eps)).astype(o.dtype)


def split_heads(t, n_heads):
    b, l, _ = t.shape
    return t.reshape(b, l, n_heads, -1).transpose(0, 2, 1, 3)


def merge_heads(t):
    b, h, l, d = t.shape
    return t.transpose(0, 2, 1, 3).reshape(b, l, h * d)


def rotary_every_two(t):
    seq, dk = t.shape[2], t.shape[3]
    inv_freq = 1.0 / (ROPE_BASE ** jnp.linspace(0.0, 1.0, dk // 2, dtype=jnp.float32))
    ang = jnp.arange(seq, dtype=jnp.float32)[:, None] * inv_freq[None, :]
    sin, cos = jnp.sin(ang), jnp.cos(ang)
    tf = t.astype(jnp.float32)
    t1, t2 = tf[..., 0::2], tf[..., 1::2]
    out = jnp.stack([t1 * cos - t2 * sin, t1 * sin + t2 * cos], axis=-1).reshape(t.shape)
    return out.astype(t.dtype)


def chunked_gated_linear_attention(q, k, v, log_decay):
    bsz, nh, seq, dk = q.shape
    dv = v.shape[-1]
    dg = log_decay.shape[-1]
    n_chunks = seq // CHUNK

    def to_chunks(t):
        return t.reshape(bsz, nh, n_chunks, CHUNK, t.shape[-1]).transpose(2, 0, 1, 3, 4)

    qc, kc, vc = to_chunks(q), to_chunks(k), to_chunks(v)
    gc = to_chunks(log_decay.astype(jnp.float32))
    causal = jnp.tril(jnp.ones((CHUNK, CHUNK), dtype=bool))[:, :, None]

    def step(state, chunk):
        qi, ki, vi, gi = chunk
        b = jnp.cumsum(gi, axis=2)
        b_last = b[:, :, -1:, :]
        o_inter = jnp.einsum('bhcd,bhdv->bhcv', qi * jnp.exp(b), state)
        rel = jnp.where(causal, b[:, :, :, None, :] - b[:, :, None, :, :], -jnp.inf)
        if dg == 1:
            scores = jnp.einsum('bhid,bhjd->bhij', qi, ki) * jnp.exp(rel[..., 0])
        else:
            scores = jnp.sum(qi[:, :, :, None, :] * ki[:, :, None, :, :] * jnp.exp(rel), axis=-1)
        o = o_inter + jnp.einsum('bhij,bhjv->bhiv', scores, vi)
        state = state * jnp.swapaxes(jnp.exp(b_last), -1, -2) + jnp.einsum(
            'bhcd,bhcv->bhdv', ki * jnp.exp(b_last - b), vi)
        return state, o

    state0 = jnp.zeros((bsz, nh, dk, dv), jnp.float32)
    _, oc = lax.scan(step, state0, (qc, kc, vc, gc))
    return oc.transpose(1, 2, 0, 3, 4).reshape(bsz, nh, seq, dv).astype(v.dtype)


def hybrid_mixer(xn, w_in, lb, w_gk_up, b_gk, gn_a, gn_c, w_br_a, w_br_b, w_br_c, w_out):
    bsz, seq, _ = xn.shape
    proj = jnp.einsum('bld,dp->blp', xn, w_in)
    (a_q, a_f, a_i, a_g, b_q, b_k, b_v, b_g,
     c_q, c_k, c_v, c_g, c_r, gate_logits) = jnp.split(proj, SPLIT_POINTS, axis=-1)

    zf = a_f.astype(jnp.float32)
    lbf = lb.astype(jnp.float32)
    log_f = jnp.logaddexp(jnp.log(lbf), jnp.log1p(-lbf) + jax.nn.log_sigmoid(zf))
    k_a = ((1.0 - lbf) * jax.nn.sigmoid(-zf)).astype(xn.dtype)
    q_a = split_heads(jax.nn.silu(a_q), A_HEADS) * (A_EXPAND ** -0.5)
    o_a = chunked_gated_linear_attention(q_a, split_heads(k_a, A_HEADS), split_heads(a_i, A_HEADS),
                                         split_heads(log_f, A_HEADS))
    o_a = merge_heads(rmsnorm(o_a, gn_a)) * jax.nn.silu(a_g)

    q_b = rotary_every_two(split_heads(b_q, B_HEADS))
    k_b = rotary_every_two(split_heads(b_k, B_HEADS)) * (B_DK ** -0.5)
    log_gamma = jnp.log(1.0 - 2.0 ** (-5.0 - jnp.arange(B_HEADS, dtype=jnp.float32)))
    g_b = jnp.broadcast_to(log_gamma[None, :, None, None], (bsz, B_HEADS, seq, 1))
    o_b = chunked_gated_linear_attention(q_b, k_b, split_heads(b_v, B_HEADS), g_b)
    o_b = merge_heads(head_groupnorm(o_b)) * jax.nn.silu(b_g)

    gk_logits = jnp.einsum('blr,rk->blk', c_r, w_gk_up) + b_gk
    log_gk = jax.nn.log_sigmoid(gk_logits.astype(jnp.float32)) / GK_NORMALIZER
    q_c = split_heads(c_q, C_HEADS) * (C_DK ** -0.5)
    o_c = chunked_gated_linear_attention(q_c, split_heads(c_k, C_HEADS), split_heads(c_v, C_HEADS),
                                         split_heads(log_gk, C_HEADS))
    o_c = merge_heads(rmsnorm(o_c, gn_c)) * jax.nn.silu(c_g)

    gates = jax.nn.sigmoid(gate_logits).reshape(bsz, seq, N_BRANCHES, D_MODEL)
    merged = (gates[:, :, 0] * jnp.einsum('blc,cd->bld', o_a, w_br_a)
              + gates[:, :, 1] * jnp.einsum('blc,cd->bld', o_b, w_br_b)
              + gates[:, :, 2] * jnp.einsum('blc,cd->bld', o_c, w_br_c))
    return jnp.einsum('bld,de->ble', merged, w_out)


def swiglu_ffn(xn, w_gate, w_up, w_down):
    h = jax.nn.silu(jnp.einsum('bld,df->blf', xn, w_gate)) * jnp.einsum('bld,df->blf', xn, w_up)
    return jnp.einsum('blf,fd->bld', h, w_down)


def setup_inputs(seed: int = 0) -> dict:
    key = jax.random.key(seed)
    ks = jax.random.split(key, 17)
    f32 = jnp.float32
    nrm = jax.random.normal
    return {
        "x": nrm(ks[0], (BATCH, SEQ, D_MODEL), f32),
        "norm_mix": 1.0 + 0.02 * nrm(ks[1], (DEPTH, D_MODEL), f32),
        "w_in": nrm(ks[2], (DEPTH, D_MODEL, PROJ_WIDTH), f32) * D_MODEL ** -0.5,
        "lb_logits": 0.1 * nrm(ks[3], (DEPTH, A_WIDTH), f32),
        "w_gk_up": nrm(ks[4], (DEPTH, GK_RANK, C_QK), f32) * GK_RANK ** -0.5,
        "b_gk": 0.1 * nrm(ks[5], (DEPTH, C_QK), f32),
        "gn_a": 1.0 + 0.02 * nrm(ks[6], (DEPTH, A_DV), f32),
        "gn_c": 1.0 + 0.02 * nrm(ks[7], (DEPTH, C_DV), f32),
        "w_br_a": nrm(ks[8], (DEPTH, A_WIDTH, D_MODEL), f32) * A_WIDTH ** -0.5,
        "w_br_b": nrm(ks[9], (DEPTH, B_V, D_MODEL), f32) * B_V ** -0.5,
        "w_br_c": nrm(ks[10], (DEPTH, C_V, D_MODEL), f32) * C_V ** -0.5,
        "w_out": nrm(ks[11], (DEPTH, D_MODEL, D_MODEL), f32) * D_MODEL ** -0.5,
        "norm_ffn": 1.0 + 0.02 * nrm(ks[12], (DEPTH, D_MODEL), f32),
        "w_ffn_gate": nrm(ks[13], (DEPTH, D_MODEL, FFN_HIDDEN), f32) * D_MODEL ** -0.5,
        "w_ffn_up": nrm(ks[14], (DEPTH, D_MODEL, FFN_HIDDEN), f32) * D_MODEL ** -0.5,
        "w_ffn_down": nrm(ks[15], (DEPTH, FFN_HIDDEN, D_MODEL), f32) * FFN_HIDDEN ** -0.5,
        "norm_final": 1.0 + 0.02 * nrm(ks[16], (D_MODEL,), f32),
    }


def reference(x, norm_mix, w_in, lb_logits, w_gk_up, b_gk, gn_a, gn_c, w_br_a, w_br_b, w_br_c,
              w_out, norm_ffn, w_ffn_gate, w_ffn_up, w_ffn_down, norm_final):
    lb_all = jnp.cumsum(jax.nn.softmax(lb_logits.astype(jnp.float32), axis=0), axis=0)
    lb_all = lb_all - lb_all[0:1]
    for layer in range(DEPTH):
        h = x + hybrid_mixer(rmsnorm(x, norm_mix[layer]), w_in[layer], lb_all[layer], w_gk_up[layer],
                             b_gk[layer], gn_a[layer], gn_c[layer], w_br_a[layer], w_br_b[layer],
                             w_br_c[layer], w_out[layer])
        x = h + swiglu_ffn(rmsnorm(h, norm_ffn[layer]), w_ffn_gate[layer], w_ffn_up[layer],
                           w_ffn_down[layer])
    return rmsnorm(x, norm_final)
```

```cpp
#include <hip/hip_runtime.h>
#include <cstdio>
#include <cstdint>

#ifndef MK_N_LAUNCHES
#define MK_N_LAUNCHES 1
#endif

#define LAS __attribute__((address_space(3)))
#define WAVTAB_OFF 163584
__device__ __forceinline__ int hw_slot_() { return (int)(__builtin_amdgcn_s_getreg(((6 - 1) << 11) | 4) & 0x3F); }
__device__ __forceinline__ int lane_() { int l; asm volatile("v_mbcnt_lo_u32_b32 %0, -1, 0\n\tv_mbcnt_hi_u32_b32 %0, -1, %0" : "=v"(l)); return l; }
__device__ __forceinline__ int tid_() { const int wv = *(const volatile LAS int*)(unsigned long)(WAVTAB_OFF + 4 * hw_slot_()); return (__builtin_amdgcn_readfirstlane(wv) << 6) | lane_(); }
#define GAS __attribute__((address_space(1)))

namespace pg8 {
#define PG8_LAS __attribute__((address_space(3)))
typedef unsigned short bf16_t;
typedef short bf16x8 __attribute__((ext_vector_type(8)));
typedef float f32x4 __attribute__((ext_vector_type(4)));
typedef unsigned u32x4 __attribute__((ext_vector_type(4)));
typedef unsigned u32x2 __attribute__((ext_vector_type(2)));
constexpr int BM = 256, BK = 64, HALF = 128, HTB = HALF * BK * 2, STAGE_BYTES = 8 * HTB, NXCD = 8, WGM = 8;

__host__ __device__ __forceinline__ int lds_byte(int r, int c) { const int st = (r >> 4) * 2 + (c >> 5), rr = r & 15, cc = c & 31, ob = rr * 64 + cc * 2; return st * 1024 + (ob ^ (((ob >> 9) & 1) << 5)); }
__host__ __device__ __forceinline__ void stage_rc(int b, int& R, int& C) { const int st = b / 1024, sb = b % 1024, swz = sb ^ (((sb >> 9) & 1) << 5); R = (st >> 1) * 16 + swz / 64; C = (st & 1) * 32 + (swz % 64) / 2; }
__host__ __device__ __forceinline__ int perm32(int rho) { const int n = rho >> 4, i = rho & 15; return 8 * (i >> 2) + 4 * n + (i & 3); }

struct Unit { int pm, pn; };
struct Gemm { const bf16_t* A; const bf16_t* Bt; int M, N, K, lda, amap, asl; };

struct StaticOrder {
    int nM, nN, nwg, G, c;
    __host__ __device__ void init(int M, int N, int G_, int c_) { nM = M / BM; nN = N / BM; nwg = nM * nN; G = G_; c = c_; }
    __host__ __device__ bool next(int i, Unit& u) const {
        const long L = (long)i * G + c; if (L >= nwg) return false;
        int wgid = (int)L; { const int q = nwg / NXCD, r = nwg % NXCD, xcd = wgid % NXCD, off = wgid / NXCD; wgid = (xcd < r ? xcd * (q + 1) : r * (q + 1) + (xcd - r) * q) + off; }
        const int nig = WGM * nN, gid = wgid / nig, fm = gid * WGM, gsz = (nM - fm) < WGM ? (nM - fm) : WGM;
        u.pm = fm + ((wgid % nig) % gsz); u.pn = (wgid % nig) / gsz; return true;
    }
};

struct ListOrder { int pm0, dpm, npn, count, pn0;
    __host__ __device__ bool next(int i, Unit& u) const { if (i >= count) return false; u.pm = pm0 + dpm * (i / npn); u.pn = pn0 + i % npn; return true; } };
struct TailOrder { int c, pn, nrow, nwg;
    __host__ __device__ bool next(int i, Unit& u) const { const int L = i * nwg + c; if (L >= nrow) return false; u.pm = L; u.pn = pn; return true; } };

__device__ __forceinline__ unsigned cvt_pk_bf16(float lo, float hi) { unsigned r; asm volatile("v_cvt_pk_bf16_f32 %0, %1, %2" : "=v"(r) : "v"(lo), "v"(hi)); return r; }

template <class Epi, class Sched>
__device__ __forceinline__ void gemm_phase(PG8_LAS unsigned char* lds, const Gemm g, const Sched& S, const Epi& E) {
    int tid = tid_(); asm volatile("" : "+v"(tid));
    const int wid = __builtin_amdgcn_readfirstlane(tid >> 6), lane = tid & 63, wr = wid >> 2, wc = wid & 3, fr = lane & 15, fq = lane >> 4;
    const int K = g.K, nt = K / BK, lda = g.lda;
    unsigned voffA[2], voffB[2];
#pragma unroll
    for (int i = 0; i < 2; ++i) { int R, C; stage_rc(tid * 16 + i * 8192, R, C); const int Rb = Epi::PERM ? ((R & ~31) + perm32(R & 31)) : R;
        voffA[i] = (unsigned)(R * lda + C) * 2u; voffB[i] = (unsigned)(Rb * K + C) * 2u; }
    const size_t kstep = (size_t)(BK * 2);
    const size_t hstepA = (size_t)HALF * lda * 2, hstepB = (size_t)HALF * K * 2;
    const size_t tstepA = 2 * hstepA, tstepB = 2 * hstepB;
    const unsigned ldsw = (unsigned)wid * 1024u;
    const int aoff = lds_byte(wr * 64 + fr, fq * 8), boff = lds_byte(wc * 32 + fr, fq * 8);
#define PG8_ABASE(u) ((const char*)g.A + (size_t)(g.amap ? ((((u).pm >> 3) << 4) + (g.asl << 3) + ((u).pm & 7)) : (u).pm) * tstepA)
#define PG8_BBASE(u) ((const char*)g.Bt + (size_t)(u).pn * tstepB)
#define PG8_SA(b, h) (((b) * 2 + (h)) * HTB)
#define PG8_SB(b, h) ((4 + (b) * 2 + (h)) * HTB)
#define PG8_STAGE(bufoff, gbase, voff) do { _Pragma("unroll") for (int _i = 0; _i < 2; ++_i) { unsigned vo_ = (voff)[_i]; asm volatile("" : "+v"(vo_));     \
        __builtin_amdgcn_global_load_lds((const unsigned*)((const char*)(gbase) + vo_), (PG8_LAS unsigned*)(lds + (bufoff) + ldsw + _i * 8192), 16, 0, 0); } } while (0)
#define PG8_LDA(dst, b, h) do { _Pragma("unroll") for (int m = 0; m < 4; ++m) _Pragma("unroll") for (int k = 0; k < 2; ++k) dst[m][k] = *(const PG8_LAS bf16x8*)(lds + PG8_SA(b, h) + aoff + m * 2048 + k * 1024); } while (0)
#define PG8_LDB(dst, b, h) do { _Pragma("unroll") for (int n = 0; n < 2; ++n) _Pragma("unroll") for (int k = 0; k < 2; ++k) dst[n][k] = *(const PG8_LAS bf16x8*)(lds + PG8_SB(b, h) + boff + n * 2048 + k * 1024); } while (0)
#define PG8_MMA(ai, bj, At, Bt) do { __builtin_amdgcn_s_setprio(1); _Pragma("unroll") for (int m = 0; m < 4; ++m) _Pragma("unroll") for (int n = 0; n < 2; ++n) _Pragma("unroll") for (int k = 0; k < 2; ++k) \
        acc[ai][bj][m][n] = __builtin_amdgcn_mfma_f32_16x16x32_bf16(Bt[n][k], At[m][k], acc[ai][bj][m][n], 0, 0, 0); __builtin_amdgcn_s_setprio(0); } while (0)
#define PG8_MMA0(ai, bj, At, Bt) do { __builtin_amdgcn_s_setprio(1); _Pragma("unroll") for (int m = 0; m < 4; ++m) _Pragma("unroll") for (int n = 0; n < 2; ++n) { \
        acc[ai][bj][m][n] = __builtin_amdgcn_mfma_f32_16x16x32_bf16(Bt[n][0], At[m][0], (f32x4){0.f, 0.f, 0.f, 0.f}, 0, 0, 0); \
        acc[ai][bj][m][n] = __builtin_amdgcn_mfma_f32_16x16x32_bf16(Bt[n][1], At[m][1], acc[ai][bj][m][n], 0, 0, 0); } __builtin_amdgcn_s_setprio(0); } while (0)
#define PG8_WAIT_V(n) asm volatile("s_waitcnt vmcnt(" #n ")" ::: "memory")
#define PG8_WAIT_L(n) asm volatile("s_waitcnt lgkmcnt(" #n ")" ::: "memory")
#define PG8_BAR __builtin_amdgcn_s_barrier()
#define PG8_SCHED __builtin_amdgcn_sched_barrier(0)
    Unit cur, nxt; int ui = 0;
    if (!S.next(0, cur)) return;
    f32x4 acc[2][2][4][2];
    bf16x8 At[4][2], B0[2][2], B1[2][2];
    const char* cA = PG8_ABASE(cur); const char* cB = PG8_BBASE(cur);
    int rsb = 0;
    PG8_STAGE(PG8_SB(0, 0), cB, voffB); PG8_STAGE(PG8_SB(0, 1), cB + hstepB, voffB); PG8_STAGE(PG8_SA(0, 0), cA, voffA); PG8_STAGE(PG8_SA(0, 1), cA + hstepA, voffA);
    if constexpr (Epi::RSTD) E.prep(cur.pm, 0);
    if (wr == 1) PG8_BAR;
    PG8_WAIT_V(2); PG8_BAR;
    PG8_STAGE(PG8_SB(1, 0), cB + kstep, voffB); PG8_STAGE(PG8_SA(1, 0), cA + kstep, voffA); PG8_STAGE(PG8_SB(1, 1), cB + hstepB + kstep, voffB);
    PG8_WAIT_V(6); PG8_BAR;
    for (;;) {
        const bool has_next = S.next(ui + 1, nxt);
        const char* nA = has_next ? PG8_ABASE(nxt) : cA; const char* nB = has_next ? PG8_BBASE(nxt) : cB;
#define PG8_ITER(T, FIRST) { const int t = (T); const bool last = (t == nt - 2); \
            const char* a1 = cA + (size_t)(t + 1) * kstep; \
            const char* a2 = last ? nA : cA + (size_t)(t + 2) * kstep; const char* b2 = last ? nB : cB + (size_t)(t + 2) * kstep; \
            const char* a3 = a2 + kstep; const char* b3 = b2 + kstep; \
            if constexpr (Epi::MID) { if (!(FIRST) && (t == 8 || t == 16)) E.mid(acc, cur, t, wr, wc, fr, fq); } \
              \
            PG8_LDB(B0, 0, 0); PG8_LDB(B1, 0, 1); PG8_SCHED; PG8_LDA(At, 0, 0); PG8_STAGE(PG8_SA(1, 1), a1 + hstepA, voffA); \
            PG8_WAIT_V(8); PG8_WAIT_L(0); PG8_BAR; if (FIRST) { PG8_MMA0(0, 0, At, B0); PG8_MMA0(0, 1, At, B1); } else { PG8_MMA(0, 0, At, B0); PG8_MMA(0, 1, At, B1); } PG8_BAR; PG8_SCHED; \
              \
            PG8_LDA(At, 0, 1); PG8_STAGE(PG8_SB(0, 0), b2, voffB); PG8_STAGE(PG8_SB(0, 1), b2 + hstepB, voffB); PG8_STAGE(PG8_SA(0, 0), a2, voffA); \
            PG8_WAIT_V(8); PG8_WAIT_L(0); PG8_BAR; if (FIRST) { PG8_MMA0(1, 0, At, B0); PG8_MMA0(1, 1, At, B1); } else { PG8_MMA(1, 0, At, B0); PG8_MMA(1, 1, At, B1); } PG8_BAR; PG8_SCHED; \
              \
            PG8_LDB(B0, 1, 0); PG8_LDB(B1, 1, 1); PG8_SCHED; PG8_LDA(At, 1, 0); PG8_STAGE(PG8_SA(0, 1), a2 + hstepA, voffA); \
            PG8_WAIT_V(8); PG8_WAIT_L(0); PG8_BAR; PG8_MMA(0, 0, At, B0); PG8_MMA(0, 1, At, B1); PG8_BAR; PG8_SCHED; \
              \
            PG8_LDA(At, 1, 1); PG8_STAGE(PG8_SB(1, 0), b3, voffB); PG8_STAGE(PG8_SB(1, 1), b3 + hstepB, voffB); PG8_STAGE(PG8_SA(1, 0), a3, voffA); \
            PG8_WAIT_V(8); PG8_WAIT_L(0); PG8_BAR; PG8_MMA(1, 0, At, B0); PG8_MMA(1, 1, At, B1); PG8_BAR; PG8_SCHED; }
        PG8_ITER(0, 1)
        for (int tt_ = 2; tt_ < nt; tt_ += 2) PG8_ITER(tt_, 0)
        if constexpr (Epi::ALIGN) { if (wr == 0) PG8_BAR; }
        E(acc, cur, wr, wc, fr, fq, rsb);
        if (!has_next) break;
        if constexpr (Epi::RSTD) { if (nxt.pm != cur.pm) { rsb ^= 1; E.prep(nxt.pm, rsb); } }
        cur = nxt; cA = nA; cB = nB; ++ui;
        if constexpr (Epi::ALIGN) { if (wr == 1) PG8_BAR; }
    }
    PG8_WAIT_V(0);
    if constexpr (!Epi::ALIGN) { if (wr == 0) PG8_BAR; }
    PG8_BAR;
#undef PG8_ABASE
#undef PG8_BBASE
#undef PG8_SA
#undef PG8_SB
#undef PG8_STAGE
#undef PG8_LDA
#undef PG8_LDB
#undef PG8_MMA
#undef PG8_WAIT_V
#undef PG8_ITER
#undef PG8_MMA0
#undef PG8_WAIT_L
#undef PG8_BAR
#undef PG8_SCHED
}
}

using pg8::bf16_t; using pg8::f32x4; using pg8::u32x4; using pg8::u32x2; using pg8::bf16x8; using pg8::cvt_pk_bf16;
typedef float f32x16 __attribute__((ext_vector_type(16)));
typedef short s16x4 __attribute__((ext_vector_type(4)));
typedef float f32x2 __attribute__((ext_vector_type(2)));

#define XB_TMO      128
#define XB_XCNT(j)  (256  + 64 * (j))
#define XB_XSUB(j)  (1280 + 64 * (j))
#define XB_XGEN(j)  (2304 + 64 * (j))
#define XB_TOP      3328
#define XB_TOPGEN   3392
#define XCD_BAR_WORDS 3456
#define XB_SPIN_CAP (1u << 18)

__device__ __forceinline__ unsigned xb_ld(unsigned* p)              { return __hip_atomic_load(p, __ATOMIC_RELAXED, __HIP_MEMORY_SCOPE_AGENT); }
__device__ __forceinline__ unsigned xb_add(unsigned* p, unsigned v) { return __hip_atomic_fetch_add(p, v, __ATOMIC_RELAXED, __HIP_MEMORY_SCOPE_AGENT); }
__device__ __forceinline__ unsigned xb_xcc_id() { return (unsigned)__builtin_amdgcn_s_getreg((3 << 11) | 20) & 0xFu; }
#define XB_SPIN(cond, bar) do { unsigned _sp = 0; while (cond) { __builtin_amdgcn_s_sleep(1); \
    if ((++_sp & 255u) == 0u) { if (xb_ld(&(bar)[XB_TMO])) break; if (_sp > XB_SPIN_CAP) { atomicAdd(&(bar)[XB_TMO], 1u); break; } } } } while (0)

struct XcdBarrier { unsigned* bar; unsigned x; volatile LAS unsigned* st; };

__device__ __forceinline__ XcdBarrier xcd_barrier_post(unsigned* bar, volatile LAS unsigned* st) {
    XcdBarrier b; b.bar = bar; b.x = xb_xcc_id(); b.st = st;
    if (tid_() == 0) (void)xb_add(&bar[XB_XCNT(b.x)], 1u);
    return b;
}
__device__ __forceinline__ void xcd_barrier_complete(unsigned* bar, unsigned x, unsigned& nloc, unsigned& nx) {
    const unsigned G = gridDim.x * gridDim.y * gridDim.z;
    unsigned sum, cnt, mine, sp = 0u;
    for (;;) {
        sum = 0u; cnt = 0u; mine = 0u;
#pragma unroll
        for (unsigned j = 0; j < 16; ++j) { const unsigned c = xb_ld(&bar[XB_XCNT(j)]); sum += c; cnt += (c > 0u) ? 1u : 0u; mine = (j == x) ? c : mine; }
        if (sum == G) break;
        __builtin_amdgcn_s_sleep(1);
        if ((++sp & 255u) == 0u) { if (xb_ld(&bar[XB_TMO])) break; if (sp > XB_SPIN_CAP) { atomicAdd(&bar[XB_TMO], 1u); break; } }
    }
    nloc = mine > 0u ? mine : 1u; nx = cnt > 0u ? cnt : 1u;
}
__device__ __forceinline__ void xcd_barrier(const XcdBarrier& b) {
    asm volatile("s_waitcnt vmcnt(0)" ::: "memory");
    __syncthreads();
    if (tid_() == 0) {
        unsigned* bar = b.bar;
        __builtin_amdgcn_s_waitcnt(0);
        unsigned nloc = b.st[0], nx = b.st[1];
        if (nloc == 0u) { xcd_barrier_complete(bar, b.x, nloc, nx); b.st[0] = nloc; b.st[1] = nx; }
        const unsigned old = xb_add(&bar[XB_XSUB(b.x)], 1u);
        const unsigned gen = old / nloc;
        if (old + 1u == (gen + 1u) * nloc) {
            __builtin_amdgcn_fence(__ATOMIC_RELEASE, "agent");
            asm volatile("s_waitcnt vmcnt(0)" ::: "memory");
            const unsigned og = xb_add(&bar[XB_TOP], 1u);
            const unsigned tg = og / nx;
            if (og + 1u == (tg + 1u) * nx) xb_add(&bar[XB_TOPGEN], 1u);
            else XB_SPIN(xb_ld(&bar[XB_TOPGEN]) == tg, bar);
            __builtin_amdgcn_fence(__ATOMIC_ACQUIRE, "agent");
            xb_add(&bar[XB_XGEN(b.x)], 1u);
            asm volatile("s_waitcnt vmcnt(0)" ::: "memory");
        } else {
            XB_SPIN(xb_ld(&bar[XB_XGEN(b.x)]) == gen, bar);
            __builtin_amdgcn_fence(__ATOMIC_ACQUIRE, "agent");
            asm volatile("s_waitcnt vmcnt(0)" ::: "memory");
        }
    }
    __syncthreads();
}

constexpr int D = 1024, NBATCH = 16, SEQ = 4096, DEPTH = 4;
constexpr int M = NBATCH * SEQ;
constexpr int NSL = 2;
constexpr int MS = M / NSL;
constexpr int SSL = SEQ / NSL;
constexpr int PW = 8208;
constexpr int PN = 8448;
constexpr int FF = 2816, GU = 2 * FF;
constexpr float NORM_EPS = 1e-6f;
constexpr int REFROW = 31;

constexpr size_t MiB = (size_t)1 << 20;
constexpr size_t WS_CTL = 0, CTL_ZERO_BYTES = 64 * 1024;
constexpr int CW_BAR = 4096;
constexpr size_t WS_ROPE = 1 * MiB;
constexpr size_t WS_LB = 2 * MiB;
constexpr size_t WS_SSQM = 860 * MiB + 96 * MiB;
constexpr size_t WS_SSQF = WS_SSQM + (size_t)M * 64;
constexpr size_t WS_WIN = 4 * MiB,  WIN_L  = (size_t)PN * D * 2;
constexpr size_t WS_WBR = 70 * MiB, WBR_L  = (size_t)1024 * 1536 * 2;
constexpr size_t WS_WOUT = 82 * MiB, WOUT_L = (size_t)1024 * 1024 * 2;
constexpr size_t WS_WGU = 106 * MiB, WGU_L = (size_t)GU * D * 2;
constexpr size_t WS_WDN = 150 * MiB, WDN_L = (size_t)D * FF * 2;
constexpr size_t WS_XB = 172 * MiB;
constexpr size_t WS_PROJ = 300 * MiB;
constexpr size_t WS_O = 860 * MiB;
constexpr size_t WS_STATE = 964 * MiB;
constexpr size_t WS_ELP = 976 * MiB;
constexpr size_t WS_DEC = 977 * MiB;
constexpr size_t WS_END = 981 * MiB;
static_assert(WS_WIN + DEPTH * WIN_L <= WS_WBR && WS_WBR + DEPTH * WBR_L <= WS_WOUT && WS_WOUT + DEPTH * WOUT_L <= WS_WGU && WS_WGU + DEPTH * WGU_L <= WS_WDN && WS_WDN + DEPTH * WDN_L <= WS_XB, "weights map");
static_assert(WS_SSQF + (size_t)M * 64 <= WS_STATE && WS_STATE + 192 * 65536 <= WS_ELP && WS_ELP + 192 * 512 <= WS_END, "misc map");
constexpr size_t PO_AQ = 0, PO_AK = (size_t)MS * 512, PO_ALG = (size_t)MS * 1024, PO_AV = (size_t)MS * 1536, PO_AOG = (size_t)MS * 2048;
constexpr size_t PO_BQ = (size_t)MS * 2560, PO_BK = PO_BQ + (size_t)MS * 256, PO_BV = PO_BK + (size_t)MS * 256, PO_BOG = PO_BV + (size_t)MS * 512;
constexpr size_t PO_CQ = PO_BOG + (size_t)MS * 512, PO_CK = PO_CQ + (size_t)MS * 256, PO_CV = PO_CK + (size_t)MS * 256, PO_COG = PO_CV + (size_t)MS * 512, PO_CLG = PO_COG + (size_t)MS * 512;
constexpr size_t PO_MG = PO_CLG + (size_t)MS * 256, PO_END = PO_MG + (size_t)MS * 3072;
static_assert(PO_END == (size_t)MS * 8960 && WS_PROJ + PO_END * 2 <= WS_O && WS_O + (size_t)MS * 1536 * 2 <= WS_SSQM, "proj map");
constexpr size_t DO_ACT = 0, DO_GP = (size_t)MS * FF * 2;
static_assert(DO_GP + (size_t)MS * D * 2 <= (size_t)M * D * 4, "d_out scratch map");

constexpr int RING_BYTES = 131072;
constexpr int LBV_OFF = 131072 + 2048, BGK_OFF = 131072 + 4096;
constexpr int RSTD_OFF = 131072;
constexpr int MISC_OFF = 163328;
constexpr int LDS_BYTES = 163840;
constexpr int NPH = 2 + DEPTH * NSL * 6;

struct Params {
    const float* in[17];
    float* out;
    unsigned char* ws;
    int ph_lo, ph_hi;
};

#define LDS_WAIT() asm volatile("s_waitcnt lgkmcnt(0)" ::: "memory")
__device__ __forceinline__ unsigned f2bf(float f) { unsigned u = __builtin_bit_cast(unsigned, f); return (u + 0x7fffu + ((u >> 16) & 1u)) >> 16; }
__device__ __forceinline__ unsigned pk2(float lo, float hi) { return f2bf(lo) | (f2bf(hi) << 16); }
__device__ __forceinline__ float bf_lo(unsigned w) { return __builtin_bit_cast(float, w << 16); }
__device__ __forceinline__ float bf_hi(unsigned w) { return __builtin_bit_cast(float, w & 0xffff0000u); }
__device__ __forceinline__ unsigned pk2h(float lo, float hi) { typedef _Float16 h2 __attribute__((ext_vector_type(2))); h2 v = {(_Float16)lo, (_Float16)hi}; return __builtin_bit_cast(unsigned, v); }
__device__ __forceinline__ float h_lo(unsigned w) { typedef _Float16 h2 __attribute__((ext_vector_type(2))); h2 v = __builtin_bit_cast(h2, w); return (float)v.x; }
__device__ __forceinline__ float h_hi(unsigned w) { typedef _Float16 h2 __attribute__((ext_vector_type(2))); h2 v = __builtin_bit_cast(h2, w); return (float)v.y; }
__device__ __forceinline__ float ex2_(float x) { return __builtin_amdgcn_exp2f(x); }
__device__ __forceinline__ float exp_(float x) { return __builtin_amdgcn_exp2f(x * 1.4426950408889634f); }
__device__ __forceinline__ float log_(float x) { return __builtin_amdgcn_logf(x) * 0.6931471805599453f; }
__device__ __forceinline__ float sigmoidf_(float x) { return __builtin_amdgcn_rcpf(1.0f + __builtin_amdgcn_exp2f(x * -1.4426950408889634f)); }
__device__ __forceinline__ unsigned q8_(float s) { return (unsigned)__builtin_amdgcn_fmed3f(s * 256.0f + 0.5f, 1.0f, 255.0f); }
__device__ __forceinline__ unsigned q8c_(float t) { return (unsigned)__builtin_amdgcn_fmed3f(t, 1.0f, 255.0f); }
__device__ __forceinline__ unsigned q8x4(float a, float b, float c, float d) { return q8_(a) | (q8_(b) << 8) | (q8_(c) << 16) | (q8_(d) << 24); }
__device__ __forceinline__ float ub0(unsigned w) { return (float)(w & 0xffu); }
__device__ __forceinline__ float ub1(unsigned w) { return (float)((w >> 8) & 0xffu); }
__device__ __forceinline__ float ub2(unsigned w) { return (float)((w >> 16) & 0xffu); }
__device__ __forceinline__ float ub3(unsigned w) { return (float)(w >> 24); }
#define SCHED_FENCE() __builtin_amdgcn_sched_barrier(0)
template <int N> __device__ __forceinline__ void sigmoidN(const float (&x)[N], float (&s)[N]) {
    float t[N];
#pragma unroll
    for (int j = 0; j < N; ++j) t[j] = x[j] * -1.4426950408889634f;
    SCHED_FENCE();
#pragma unroll
    for (int j = 0; j < N; ++j) t[j] = __builtin_amdgcn_exp2f(t[j]);
    SCHED_FENCE();
#pragma unroll
    for (int j = 0; j < N; ++j) t[j] = 1.0f + t[j];
    SCHED_FENCE();
#pragma unroll
    for (int j = 0; j < N; ++j) s[j] = __builtin_amdgcn_rcpf(t[j]);
    SCHED_FENCE();
}
template <int CTRL> __device__ __forceinline__ float dpp_f(float v) { return __builtin_bit_cast(float, __builtin_amdgcn_update_dpp(0, __builtin_bit_cast(int, v), CTRL, 0xF, 0xF, false)); }
__device__ __forceinline__ float xsum16(float v) { return v + __builtin_bit_cast(float, __builtin_amdgcn_ds_swizzle(__builtin_bit_cast(int, v), 0x401F)); }
__device__ __forceinline__ float xsum32(float v) { unsigned a = __builtin_bit_cast(unsigned, v), b = a;
    asm volatile("s_nop 1\n\tv_permlane32_swap_b32 %0, %1\n\ts_nop 1" : "+v"(a), "+v"(b)); return __builtin_bit_cast(float, a) + __builtin_bit_cast(float, b); }
__device__ __forceinline__ float wave_sum(float v) {
    v += dpp_f<0xB1>(v); v += dpp_f<0x4E>(v); v += dpp_f<0x124>(v); v += dpp_f<0x128>(v);
    return xsum32(xsum16(v));
}
__device__ __forceinline__ float ssq_row(const float* p) { const f32x4 a = *(const f32x4*)p, b = *(const f32x4*)(p + (size_t)65536 * 4), c = *(const f32x4*)(p + (size_t)65536 * 8), d = *(const f32x4*)(p + (size_t)65536 * 12); return ((a[0] + a[1]) + (a[2] + a[3])) + ((b[0] + b[1]) + (b[2] + b[3])) + ((c[0] + c[1]) + (c[2] + c[3])) + ((d[0] + d[1]) + (d[2] + d[3])); }
__device__ __forceinline__ int grow_of_tile(int pm, int sl) { return ((((pm >> 3) << 4) + (sl << 3) + (pm & 7)) << 8); }
__device__ __forceinline__ float lg2gamma(int h) { return __log2f(1.0f - exp2f(-5.0f - (float)h)); }


constexpr int RSTD_BUF2 = 6144;
__device__ __forceinline__ void panel_rstd_fill(LAS unsigned char* lds, const float* ssq, int g0, int buf) {
    int t_ = tid_(); asm volatile("" : "+v"(t_));
    const int row = t_ >> 1, hp = t_ & 1;
    const float* p = ssq + ((size_t)(2 * hp) * M + g0 + row) * 4;
    const f32x4 a = *(const f32x4*)p, b = *(const f32x4*)(p + (size_t)M * 4);
    float s = ((a[0] + a[1]) + (a[2] + a[3])) + ((b[0] + b[1]) + (b[2] + b[3]));
    s += dpp_f<0xB1>(s);
    if (hp == 0) ((LAS float*)(lds + RSTD_OFF + buf * RSTD_BUF2))[row] = __builtin_amdgcn_rsqf(s * (1.0f / 1024.0f) + NORM_EPS);
}

struct EpiInProj {
    static constexpr bool PERM = true, AFTER_DRAIN = false, MID = false, ALIGN = true, RSTD = true;
    const float* ssq;
    const float* lb;
    const float* bgk;
    const float* rope;
    bf16_t* pb;
    int sl; LAS unsigned char* lds; float* dec;
    __device__ __forceinline__ void prep(int pm, int buf) const { panel_rstd_fill(lds, ssq, grow_of_tile(pm, sl), buf); }
    __device__ __forceinline__ void operator()(const f32x4 (&acc)[2][2][4][2], const pg8::Unit& u, int wr, int wc, int fr, int fq, int rsb) const {
        asm volatile("" : "+v"(fr), "+v"(fq));
        const int pn = u.pn;
        int type, ldc, cb; size_t off; float scale = 1.0f;
        if (pn < 4)       { type = 3; off = PO_AQ;  ldc = 512; cb = pn * 128; }
        else if (pn < 6)  { type = 0; off = PO_AV;  ldc = 512; cb = (pn - 4) * 256; }
        else if (pn < 8)  { type = 1; off = PO_AOG; ldc = 512; cb = (pn - 6) * 256; }
        else if (pn == 8) { type = 4; off = PO_BQ;  ldc = 256; cb = 0; }
        else if (pn == 9) { type = 5; off = PO_BK;  ldc = 256; cb = 0; }
        else if (pn < 12) { type = 0; off = PO_BV;  ldc = 512; cb = (pn - 10) * 256; }
        else if (pn < 14) { type = 1; off = PO_BOG; ldc = 512; cb = (pn - 12) * 256; }
        else if (pn == 14){ type = 0; off = PO_CQ;  ldc = 256; cb = 0; scale = 0.125f; }
        else if (pn == 15){ type = 0; off = PO_CK;  ldc = 256; cb = 0; }
        else if (pn < 18) { type = 0; off = PO_CV;  ldc = 512; cb = (pn - 16) * 256; }
        else if (pn < 20) { type = 1; off = PO_COG; ldc = 512; cb = (pn - 18) * 256; }
        else if (pn == 20){ type = 6; off = PO_CLG; ldc = 256; cb = 0; }
        else              { type = 2; off = PO_MG;  ldc = 0; cb = 0; }
        const int rl0 = u.pm * 256 + wr * 64 + fr, c8 = wc * 32 + 8 * fq, gl0 = grow_of_tile(u.pm, sl) + wr * 64 + fr;
        float rs[2][4];
#pragma unroll
        for (int ai = 0; ai < 2; ++ai)
#pragma unroll
            for (int m = 0; m < 4; ++m) rs[ai][m] = ((const LAS float*)(lds + RSTD_OFF + rsb * RSTD_BUF2))[wr * 64 + fr + ai * 128 + m * 16];
        bf16_t* dst = pb + off;
        if (type == 2) {
            unsigned char* g8 = (unsigned char*)dst + ((size_t)(u.pm * 12 + (pn - 21)) << 16) + (size_t)((((wr * 4 + wc) * 64) + fq * 16 + fr) * 16);
#pragma unroll
            for (int ai = 0; ai < 2; ++ai)
#pragma unroll
                for (int m = 0; m < 4; ++m) { u32x4 w; const float rn = rs[ai][m] * -1.4426950408889634f;
#pragma unroll
                    for (int bj = 0; bj < 2; ++bj) { f32x4 xa = acc[ai][bj][m][0] * rn, xb = acc[ai][bj][m][1] * rn;
                        SCHED_FENCE();
#pragma unroll
                        for (int j = 0; j < 4; ++j) { xa[j] = __builtin_amdgcn_exp2f(xa[j]); xb[j] = __builtin_amdgcn_exp2f(xb[j]); }
                        SCHED_FENCE();
                        xa = xa + 1.0f; xb = xb + 1.0f;
                        SCHED_FENCE();
#pragma unroll
                        for (int j = 0; j < 4; ++j) { xa[j] = __builtin_amdgcn_rcpf(xa[j]); xb[j] = __builtin_amdgcn_rcpf(xb[j]); }
                        SCHED_FENCE();
                        xa = xa * 256.0f + 0.5f; xb = xb * 256.0f + 0.5f;
                        const unsigned lo = q8c_(xa[0]) | (q8c_(xa[1]) << 8) | (q8c_(xa[2]) << 16) | (q8c_(xa[3]) << 24), hi = q8c_(xb[0]) | (q8c_(xb[1]) << 8) | (q8c_(xb[2]) << 16) | (q8c_(xb[3]) << 24);
                        if (bj == 0) { w.x = lo; w.y = hi; } else { w.z = lo; w.w = hi; } }
                    *(u32x4*)(g8 + (ai * 4 + m) * 8192) = w; asm volatile("" ::: "memory"); }
        } else if (type < 2) {
#pragma unroll
            for (int ai = 0; ai < 2; ++ai)
#pragma unroll
                for (int m = 0; m < 4; ++m) { const int r = rl0 + ai * 128 + m * 16;
#pragma unroll
                    for (int bj = 0; bj < 2; ++bj) { const float rsc = rs[ai][m] * scale, rn = rs[ai][m] * -1.4426950408889634f;
                        f32x4 va = acc[ai][bj][m][0] * rsc, vb = acc[ai][bj][m][1] * rsc;
                        if (type != 0) { f32x4 ea = acc[ai][bj][m][0] * rn, eb = acc[ai][bj][m][1] * rn;
                            SCHED_FENCE();
#pragma unroll
                            for (int j = 0; j < 4; ++j) { ea[j] = __builtin_amdgcn_exp2f(ea[j]); eb[j] = __builtin_amdgcn_exp2f(eb[j]); }
                            SCHED_FENCE();
                            ea = ea + 1.0f; eb = eb + 1.0f;
                            SCHED_FENCE();
#pragma unroll
                            for (int j = 0; j < 4; ++j) { ea[j] = __builtin_amdgcn_rcpf(ea[j]); eb[j] = __builtin_amdgcn_rcpf(eb[j]); }
                            SCHED_FENCE();
                            va = va * ea; vb = vb * eb; }
                        u32x4 w;
                        w.x = cvt_pk_bf16(va[0], va[1]); w.y = cvt_pk_bf16(va[2], va[3]); w.z = cvt_pk_bf16(vb[0], vb[1]); w.w = cvt_pk_bf16(vb[2], vb[3]);
                        *(u32x4*)(dst + (size_t)r * ldc + cb + c8 + bj * 128) = w; }
                    asm volatile("" ::: "memory"); }
        } else if (type == 3) {
            bf16_t* dq = pb + PO_AQ; bf16_t* dk = pb + PO_AK;
#pragma unroll
            for (int ai = 0; ai < 2; ++ai)
#pragma unroll
                for (int n = 0; n < 2; ++n) { const int cc = cb + c8 + 4 * n;
                    const f32x4 lbv = *(const LAS f32x4*)(lds + LBV_OFF + cc * 4);
                    float lg[4][4];
#pragma unroll
                    for (int m = 0; m < 4; ++m) { float tt[4]; const float rn = rs[ai][m] * -1.4426950408889634f;
#pragma unroll
                        for (int j = 0; j < 4; ++j) tt[j] = fminf(acc[ai][1][m][n][j] * rn, 115.0f);
                        SCHED_FENCE();
#pragma unroll
                        for (int j = 0; j < 4; ++j) tt[j] = __builtin_amdgcn_exp2f(tt[j]);
                        SCHED_FENCE();
#pragma unroll
                        for (int j = 0; j < 4; ++j) tt[j] = __builtin_amdgcn_rcpf(1.0f + tt[j]);
                        SCHED_FENCE();
#pragma unroll
                        for (int j = 0; j < 4; ++j) lg[m][j] = __builtin_amdgcn_logf(lbv[j] + (1.0f - lbv[j]) * tt[j]); }
                    float offs[4], rref[4];
#pragma unroll
                    for (int j = 0; j < 4; ++j) { offs[j] = 0.f; rref[j] = 0.f; }
#pragma unroll
                    for (int m = 0; m < 4; ++m) {
#pragma unroll
                        for (int j = 0; j < 4; ++j) { float v = lg[m][j];
                            v += __builtin_bit_cast(float, __builtin_amdgcn_update_dpp(0, __builtin_bit_cast(int, v), 0x111, 0xF, 0xF, true));
                            v += __builtin_bit_cast(float, __builtin_amdgcn_update_dpp(0, __builtin_bit_cast(int, v), 0x112, 0xF, 0xF, true));
                            v += __builtin_bit_cast(float, __builtin_amdgcn_update_dpp(0, __builtin_bit_cast(int, v), 0x114, 0xF, 0xF, true));
                            v += __builtin_bit_cast(float, __builtin_amdgcn_update_dpp(0, __builtin_bit_cast(int, v), 0x118, 0xF, 0xF, true));
                            const float tot = __builtin_bit_cast(float, __builtin_amdgcn_update_dpp(0, __builtin_bit_cast(int, v), 0x15F, 0xF, 0xF, false));
                            lg[m][j] = v + offs[j]; offs[j] += tot;
                            if (m == 1) rref[j] = offs[j]; } }
#pragma unroll
                    for (int m = 0; m < 4; ++m) { const int r = rl0 + ai * 128 + m * 16; float qv[4], sg[4], eq[4], ek[4], tt[4];
#pragma unroll
                        for (int j = 0; j < 4; ++j) { tt[j] = fminf(acc[ai][1][m][n][j] * (rs[ai][m] * -1.4426950408889634f), 115.0f); qv[j] = acc[ai][0][m][n][j] * rs[ai][m]; eq[j] = lg[m][j] - rref[j]; ek[j] = -eq[j]; }
                        SCHED_FENCE();
#pragma unroll
                        for (int j = 0; j < 4; ++j) { tt[j] = __builtin_amdgcn_exp2f(tt[j]); eq[j] = __builtin_amdgcn_exp2f(eq[j]); ek[j] = __builtin_amdgcn_exp2f(ek[j]); }
                        sigmoidN<4>(qv, sg);
#pragma unroll
                        for (int j = 0; j < 4; ++j) { qv[j] = qv[j] * sg[j] * 0.08838834764831845f * eq[j]; ek[j] *= (1.0f - lbv[j]) * tt[j] * __builtin_amdgcn_rcpf(1.0f + tt[j]); }
                        u32x2 wq, wk;
                        wq.x = cvt_pk_bf16(qv[0], qv[1]); wq.y = cvt_pk_bf16(qv[2], qv[3]); wk.x = cvt_pk_bf16(ek[0], ek[1]); wk.y = cvt_pk_bf16(ek[2], ek[3]);
                        const size_t o = (size_t)r * 512 + cc;
                        *(u32x2*)(dq + o) = wq; *(u32x2*)(dk + o) = wk; }
                    if (fr == 0) {
                        const int gch = (gl0 - fr + ai * 128) >> 6;
                        float* pe = dec + ((size_t)gch * 4 + pn) * 128 + c8 + 4 * n; float* pl = pe + (size_t)1024 * 4 * 128;
                        f32x4 e0, l0;
#pragma unroll
                        for (int j = 0; j < 4; ++j) { e0[j] = ex2_(rref[j]); l0[j] = ex2_(offs[j] - rref[j]); }
                        *(f32x4*)pe = e0; *(f32x4*)pl = l0; }
                    asm volatile("" ::: "memory"); }
        } else if (type == 4 || type == 5) {
#pragma unroll
            for (int bj = 0; bj < 2; ++bj) { const int c = c8 + bj * 128, hh = c >> 6, i0 = (c & 63) >> 1; const float l2g = lg2gamma(hh);
#pragma unroll
                for (int ai = 0; ai < 2; ++ai) { f32x4 csv[4][2];
#pragma unroll
                    for (int m = 0; m < 4; ++m) { const int pos = (gl0 + ai * 128 + m * 16) & (SEQ - 1); csv[m][0] = *(const f32x4*)(rope + ((size_t)pos * 32 + i0) * 2); csv[m][1] = *(const f32x4*)(rope + ((size_t)pos * 32 + i0) * 2 + 4); }
#pragma unroll
                    for (int m = 0; m < 4; ++m) { const int r = rl0 + ai * 128 + m * 16, pos = (gl0 + ai * 128 + m * 16) & (SEQ - 1), tc = pos & 63;
                        const f32x4 cs0 = csv[m][0], cs1 = csv[m][1];
                        const float fac = (type == 4) ? ex2_((float)(tc - REFROW) * l2g) : 0.125f * ex2_((float)(REFROW - tc) * l2g);
                        float v[8];
#pragma unroll
                        for (int j = 0; j < 8; ++j) v[j] = acc[ai][bj][m][j >> 2][j & 3] * rs[ai][m];
                        float o[8];
                        o[0] = v[0] * cs0[0] - v[1] * cs0[1]; o[1] = v[0] * cs0[1] + v[1] * cs0[0];
                        o[2] = v[2] * cs0[2] - v[3] * cs0[3]; o[3] = v[2] * cs0[3] + v[3] * cs0[2];
                        o[4] = v[4] * cs1[0] - v[5] * cs1[1]; o[5] = v[4] * cs1[1] + v[5] * cs1[0];
                        o[6] = v[6] * cs1[2] - v[7] * cs1[3]; o[7] = v[6] * cs1[3] + v[7] * cs1[2];
                        u32x4 w;
                        w.x = cvt_pk_bf16(o[0] * fac, o[1] * fac); w.y = cvt_pk_bf16(o[2] * fac, o[3] * fac); w.z = cvt_pk_bf16(o[4] * fac, o[5] * fac); w.w = cvt_pk_bf16(o[6] * fac, o[7] * fac);
                        *(u32x4*)(dst + (size_t)r * 256 + c) = w; asm volatile("" ::: "memory"); } } }
        } else {
#pragma unroll
            for (int bj = 0; bj < 2; ++bj) { const int c = c8 + bj * 128; float bg[8]; { const f32x4 l0 = *(const LAS f32x4*)(lds + BGK_OFF + c * 4), l1 = *(const LAS f32x4*)(lds + BGK_OFF + c * 4 + 16);
#pragma unroll
                    for (int j = 0; j < 4; ++j) { bg[j] = l0[j]; bg[4 + j] = l1[j]; } }
#pragma unroll
                for (int ai = 0; ai < 2; ++ai)
#pragma unroll
                    for (int m = 0; m < 4; ++m) { const int r = rl0 + ai * 128 + m * 16; float lg[8];
                        float xx[8], ee[8];
#pragma unroll
                        for (int j = 0; j < 8; ++j) { xx[j] = acc[ai][bj][m][j >> 2][j & 3] * rs[ai][m] + bg[j]; ee[j] = fabsf(xx[j]) * -1.4426950408889634f; }
                        SCHED_FENCE();
#pragma unroll
                        for (int j = 0; j < 8; ++j) ee[j] = __builtin_amdgcn_exp2f(ee[j]);
                        SCHED_FENCE();
#pragma unroll
                        for (int j = 0; j < 8; ++j) ee[j] = 1.0f + ee[j];
                        SCHED_FENCE();
#pragma unroll
                        for (int j = 0; j < 8; ++j) ee[j] = __builtin_amdgcn_logf(ee[j]);
                        SCHED_FENCE();
#pragma unroll
                        for (int j = 0; j < 8; ++j) lg[j] = -(fmaxf(-xx[j], 0.0f) + ee[j] * 0.6931471805599453f) * (1.0f / 16.0f);
                        u32x4 h; h.x = pk2h(lg[0], lg[1]); h.y = pk2h(lg[2], lg[3]); h.z = pk2h(lg[4], lg[5]); h.w = pk2h(lg[6], lg[7]);
                        *(u32x4*)(dst + (size_t)r * 256 + c) = h; asm volatile("" ::: "memory"); } }
        }
    }
};
struct EpiGate {
    static constexpr bool PERM = true, AFTER_DRAIN = false, MID = true, ALIGN = true, RSTD = false;
    const unsigned char* mg8; bf16_t* out;
    __device__ __forceinline__ void mid(f32x4 (&acc)[2][2][4][2], const pg8::Unit& u, int t, int wr, int wc, int fr, int fq) const {
        asm volatile("" : "+v"(fr), "+v"(fq));
        const unsigned char* tb = mg8 + ((size_t)(u.pm * 12 + u.pn + (t == 8 ? 0 : 4)) << 16) + (size_t)((((wr * 4 + wc) * 64) + fq * 16 + fr) * 16);
        u32x4 gnv[2][4], gdv[2][4];
#pragma unroll
        for (int ai = 0; ai < 2; ++ai)
#pragma unroll
            for (int m = 0; m < 4; ++m) { gnv[ai][m] = *(const u32x4*)(tb + (ai * 4 + m) * 8192); gdv[ai][m] = *(const u32x4*)(tb + 4 * 65536 + (ai * 4 + m) * 8192); }
#pragma unroll
        for (int ai = 0; ai < 2; ++ai)
#pragma unroll
            for (int m = 0; m < 4; ++m) { const u32x4 gn = gnv[ai][m], gd = gdv[ai][m];
#pragma unroll
                for (int bj = 0; bj < 2; ++bj) { const unsigned n0 = bj ? gn.z : gn.x, n1 = bj ? gn.w : gn.y, d0 = bj ? gd.z : gd.x, d1 = bj ? gd.w : gd.y;
                    f32x4& a0 = acc[ai][bj][m][0]; f32x4& a1 = acc[ai][bj][m][1];
                    a0[0] *= ub0(n0) * __builtin_amdgcn_rcpf(ub0(d0)); a0[1] *= ub1(n0) * __builtin_amdgcn_rcpf(ub1(d0));
                    a0[2] *= ub2(n0) * __builtin_amdgcn_rcpf(ub2(d0)); a0[3] *= ub3(n0) * __builtin_amdgcn_rcpf(ub3(d0));
                    a1[0] *= ub0(n1) * __builtin_amdgcn_rcpf(ub0(d1)); a1[1] *= ub1(n1) * __builtin_amdgcn_rcpf(ub1(d1));
                    a1[2] *= ub2(n1) * __builtin_amdgcn_rcpf(ub2(d1)); a1[3] *= ub3(n1) * __builtin_amdgcn_rcpf(ub3(d1)); } }
    }
    __device__ __forceinline__ void operator()(const f32x4 (&acc)[2][2][4][2], const pg8::Unit& u, int wr, int wc, int fr, int fq, int rsb) const {
        asm volatile("" : "+v"(fr), "+v"(fq));
        const int rl0 = u.pm * 256 + wr * 64 + fr, c0 = u.pn * 256 + wc * 32 + 8 * fq;
        const unsigned char* tb = mg8 + ((size_t)(u.pm * 12 + u.pn + 8) << 16) + (size_t)((((wr * 4 + wc) * 64) + fq * 16 + fr) * 16);
        const float sc = 1.0f / 256.0f;
        u32x4 gwv[2][4];
#pragma unroll
        for (int ai = 0; ai < 2; ++ai)
#pragma unroll
            for (int m = 0; m < 4; ++m) gwv[ai][m] = *(const u32x4*)(tb + (ai * 4 + m) * 8192);
#pragma unroll
        for (int ai = 0; ai < 2; ++ai)
#pragma unroll
            for (int m = 0; m < 4; ++m) { const size_t rr = (size_t)(rl0 + ai * 128 + m * 16); const u32x4 gw = gwv[ai][m];
#pragma unroll
                for (int bj = 0; bj < 2; ++bj) { const unsigned g0 = bj ? gw.z : gw.x, g1 = bj ? gw.w : gw.y; const f32x4 a0 = acc[ai][bj][m][0] * sc, a1 = acc[ai][bj][m][1] * sc; u32x4 w;
                    w.x = cvt_pk_bf16(a0[0] * ub0(g0), a0[1] * ub1(g0)); w.y = cvt_pk_bf16(a0[2] * ub2(g0), a0[3] * ub3(g0));
                    w.z = cvt_pk_bf16(a1[0] * ub0(g1), a1[1] * ub1(g1)); w.w = cvt_pk_bf16(a1[2] * ub2(g1), a1[3] * ub3(g1));
                    *(u32x4*)(out + rr * 1024 + c0 + bj * 128) = w; } }
    }
};
struct EpiResid {
    static constexpr bool PERM = true, AFTER_DRAIN = false, MID = false, ALIGN = true, RSTD = false;
    bf16_t* xb; float* ssq; int sl;
    __device__ __forceinline__ void operator()(const f32x4 (&acc)[2][2][4][2], const pg8::Unit& u, int wr, int wc, int fr, int fq, int rsb) const {
        asm volatile("" : "+v"(fr), "+v"(fq));
        const int rl0 = grow_of_tile(u.pm, sl) + wr * 64 + fr, c0 = u.pn * 256 + wc * 32 + 8 * fq;
        u32x4 xiv[2][4][2];
#pragma unroll
        for (int ai = 0; ai < 2; ++ai)
#pragma unroll
            for (int m = 0; m < 4; ++m)
#pragma unroll
                for (int bj = 0; bj < 2; ++bj) xiv[ai][m][bj] = *(const u32x4*)(xb + (size_t)(rl0 + ai * 128 + m * 16) * D + c0 + bj * 128);
#pragma unroll
        for (int ai = 0; ai < 2; ++ai)
#pragma unroll
            for (int m = 0; m < 4; ++m) { const int r = rl0 + ai * 128 + m * 16; const size_t ro = (size_t)r * D + c0; float ss = 0.f;
                u32x4 xi[2]; xi[0] = xiv[ai][m][0]; xi[1] = xiv[ai][m][1];
#pragma unroll
                for (int bj = 0; bj < 2; ++bj) { const f32x4 a0 = acc[ai][bj][m][0], a1 = acc[ai][bj][m][1]; float v[8];
                    v[0] = bf_lo(xi[bj].x) + a0[0]; v[1] = bf_hi(xi[bj].x) + a0[1]; v[2] = bf_lo(xi[bj].y) + a0[2]; v[3] = bf_hi(xi[bj].y) + a0[3];
                    v[4] = bf_lo(xi[bj].z) + a1[0]; v[5] = bf_hi(xi[bj].z) + a1[1]; v[6] = bf_lo(xi[bj].w) + a1[2]; v[7] = bf_hi(xi[bj].w) + a1[3];
                    u32x4 w; w.x = cvt_pk_bf16(v[0], v[1]); w.y = cvt_pk_bf16(v[2], v[3]); w.z = cvt_pk_bf16(v[4], v[5]); w.w = cvt_pk_bf16(v[6], v[7]);
                    *(u32x4*)(xb + ro + bj * 128) = w;
                    ss += ((v[0] * v[0] + v[1] * v[1]) + (v[2] * v[2] + v[3] * v[3])) + ((v[4] * v[4] + v[5] * v[5]) + (v[6] * v[6] + v[7] * v[7])); }
                ss = xsum32(xsum16(ss));
                if (fq == 0) ssq[((size_t)u.pn * M + r) * 4 + wc] = ss; }
    }
};
struct EpiSwiGLU {
    static constexpr bool PERM = true, AFTER_DRAIN = false, MID = false, ALIGN = true, RSTD = true;
    const float* ssq; bf16_t* act; int sl; LAS unsigned char* lds;
    __device__ __forceinline__ void prep(int pm, int buf) const { panel_rstd_fill(lds, ssq, grow_of_tile(pm, sl), buf); }
    __device__ __forceinline__ void operator()(const f32x4 (&acc)[2][2][4][2], const pg8::Unit& u, int wr, int wc, int fr, int fq, int rsb) const {
        asm volatile("" : "+v"(fr), "+v"(fq));
        const int rl0 = u.pm * 256 + wr * 64 + fr, c0 = u.pn * 128 + wc * 32 + 8 * fq;
#pragma unroll
        for (int ai = 0; ai < 2; ++ai)
#pragma unroll
            for (int m = 0; m < 4; ++m) { const int r = rl0 + ai * 128 + m * 16; const float rs = ((const LAS float*)(lds + RSTD_OFF + rsb * RSTD_BUF2))[wr * 64 + fr + ai * 128 + m * 16];
                const float rn = rs * -1.4426950408889634f;
                f32x4 ga = acc[ai][0][m][0] * rs, gb = acc[ai][0][m][1] * rs, ea = acc[ai][0][m][0] * rn, eb = acc[ai][0][m][1] * rn;
                SCHED_FENCE();
#pragma unroll
                for (int j = 0; j < 4; ++j) { ea[j] = __builtin_amdgcn_exp2f(ea[j]); eb[j] = __builtin_amdgcn_exp2f(eb[j]); }
                SCHED_FENCE();
                ea = ea + 1.0f; eb = eb + 1.0f;
                SCHED_FENCE();
#pragma unroll
                for (int j = 0; j < 4; ++j) { ea[j] = __builtin_amdgcn_rcpf(ea[j]); eb[j] = __builtin_amdgcn_rcpf(eb[j]); }
                SCHED_FENCE();
                const f32x4 aa = (ga * ea) * (acc[ai][1][m][0] * rs), ab = (gb * eb) * (acc[ai][1][m][1] * rs);
                u32x4 w; w.x = cvt_pk_bf16(aa[0], aa[1]); w.y = cvt_pk_bf16(aa[2], aa[3]); w.z = cvt_pk_bf16(ab[0], ab[1]); w.w = cvt_pk_bf16(ab[2], ab[3]);
                *(u32x4*)(act + (size_t)r * FF + c0) = w; }
    }
};

__device__ __forceinline__ void tr_item(const float* src, int lds_, int scol0, int k0, const float* scale, int smask, bf16_t* dst, int ldd, int drow0, int dcol0, LAS float* scr, int lane) {
    float wv_[32], sv_[32];
#pragma unroll
    for (int i = 0; i < 32; ++i) { const int kk = 2 * i + (lane >> 5); wv_[i] = src[(size_t)(k0 + kk) * lds_ + scol0 + (lane & 31)]; sv_[i] = scale ? scale[(k0 + kk) & smask] : 1.0f; }
#pragma unroll
    for (int i = 0; i < 32; ++i) { const int kk = 2 * i + (lane >> 5); scr[kk * 33 + (lane & 31)] = wv_[i] * sv_[i]; }
    LDS_WAIT(); asm volatile("" ::: "memory");
    const int c = lane & 7;
#pragma unroll
    for (int j = 0; j < 4; ++j) { const int n = (lane >> 3) + 8 * j; const LAS float* s = scr + (8 * c) * 33 + n;
        u32x4 o; o.x = pk2(s[0 * 33], s[1 * 33]); o.y = pk2(s[2 * 33], s[3 * 33]); o.z = pk2(s[4 * 33], s[5 * 33]); o.w = pk2(s[6 * 33], s[7 * 33]);
        *(u32x4*)(dst + (size_t)(drow0 + n) * ldd + dcol0 + k0 + 8 * c) = o; }
    LDS_WAIT(); asm volatile("" ::: "memory");
}
__device__ __forceinline__ void ph_prologue(const Params& P, LAS unsigned char* lds) {
    int tid = tid_(); asm volatile("" : "+v"(tid));
    const int lane = tid & 63, wave = __builtin_amdgcn_readfirstlane(tid >> 6);
    const int G = gridDim.x, gw = blockIdx.x * 8 + wave, NGW = G * 8;
    const size_t gt = (size_t)blockIdx.x * 512 + tid, NGT = (size_t)G * 512;
    unsigned char* ws = P.ws;
    const float* x = P.in[0]; const float* norm_mix = P.in[1]; const float* w_in = P.in[2]; const float* lb_logits = P.in[3]; const float* w_gk_up = P.in[4];
    const float* w_out = P.in[11]; const float* norm_ffn = P.in[12];
    const float* w_g = P.in[13]; const float* w_u = P.in[14]; const float* w_d = P.in[15];
    LAS float* scr = (LAS float*)(lds + wave * 16384);
    constexpr int I_IN = 16 * 256, I_BR = 3 * 8 * 32, I_OUT = 16 * 32, I_GU = 16 * (GU / 32), I_DN = (FF / 64) * 32, I_L = I_IN + I_BR + I_OUT + I_GU + I_DN;
    for (int it = gw; it < DEPTH * I_L; it += NGW) {
        const int l = it / I_L; int r = it % I_L;
        if (r < I_IN) { const int kb = r / 256, nb = r % 256; const int n0 = (nb < 160) ? nb * 32 : 5376 + (nb - 160) * 32; const int sc0 = (n0 < 1024) ? (((n0 & 255) < 128) ? (n0 >> 8) * 128 + (n0 & 255) : 512 + (n0 >> 8) * 128 + (n0 & 255) - 128) : (nb < 160) ? n0 : n0 - 240;
            tr_item(w_in + (size_t)l * D * PW, PW, sc0, kb * 64, norm_mix + l * D, 0xFFFF, (bf16_t*)(ws + WS_WIN + l * WIN_L), D, n0, 0, scr, lane); continue; }
        r -= I_IN;
        if (r < I_BR) { const int br = r / 256, kb = (r % 256) / 32, nb = r % 32;
            tr_item((br == 0 ? P.in[8] : br == 1 ? P.in[9] : P.in[10]) + (size_t)l * 512 * D, D, nb * 32, kb * 64, (br == 0 ? P.in[6] + l * 128 : br == 2 ? P.in[7] + l * 128 : nullptr), 127, (bf16_t*)(ws + WS_WBR + l * WBR_L), 1536, nb * 32, br * 512, scr, lane); continue; }
        r -= I_BR;
        if (r < I_OUT) { const int kb = r / 32, nb = r % 32;
            tr_item(w_out + (size_t)l * D * D, D, nb * 32, kb * 64, nullptr, 0, (bf16_t*)(ws + WS_WOUT + l * WOUT_L), D, nb * 32, 0, scr, lane); continue; }
        r -= I_OUT;
        if (r < I_GU) { const int kb = r / (GU / 32), nb = r % (GU / 32);
            { const int n0 = nb * 32, t = n0 >> 8, w0 = n0 & 255; const bool up = w0 >= 128;
                tr_item((up ? w_u : w_g) + (size_t)l * D * FF, FF, t * 128 + (w0 & 127), kb * 64, norm_ffn + l * D, 0xFFFF, (bf16_t*)(ws + WS_WGU + l * WGU_L), D, n0, 0, scr, lane); } continue; }
        r -= I_GU;
        { const int kb = r / 32, nb = r % 32;
            tr_item(w_d + (size_t)l * FF * D, D, nb * 32, kb * 64, nullptr, 0, (bf16_t*)(ws + WS_WDN + l * WDN_L), FF, nb * 32, 0, scr, lane); }
    }
    for (size_t it = gt; it < (size_t)DEPTH * 256 * 128; it += NGT) {
        const int l = (int)(it / (256 * 128)), rr = (int)(it % (256 * 128)), j = rr % 256, kc = rr / 256;
        float up[16];
#pragma unroll
        for (int r = 0; r < 16; ++r) up[r] = w_gk_up[((size_t)l * 16 + r) * 256 + j];
        float o[8];
#pragma unroll
        for (int kk = 0; kk < 8; ++kk) { const int k = kc * 8 + kk; const float* wr_ = w_in + ((size_t)l * D + k) * PW + 5120; float s = 0.f;
#pragma unroll
            for (int r = 0; r < 16; ++r) s += wr_[r] * up[r];
            o[kk] = s * norm_mix[l * D + k]; }
        u32x4 w; w.x = pk2(o[0], o[1]); w.y = pk2(o[2], o[3]); w.z = pk2(o[4], o[5]); w.w = pk2(o[6], o[7]);
        *(u32x4*)((bf16_t*)(ws + WS_WIN + l * WIN_L) + (size_t)(5120 + j) * D + kc * 8) = w;
    }
    for (size_t it = gt; it < (size_t)SEQ * 32; it += NGT) {
        const int pos = (int)(it >> 5), i = (int)(it & 31);
        double a = -(double)i * (9.210340371976184 / 31.0) * (1.0 / 16.0), e = 1.0, term = 1.0;
#pragma unroll 1
        for (int n = 1; n <= 18; ++n) { term *= a / (double)n; e += term; }
        e *= e; e *= e; e *= e; e *= e;
        const double th = (double)pos * e;
        const double kq = __builtin_rint(th * 0.15915494309189535);
        double rr = __builtin_fma(-kq, 6.283185307179586, th); rr = __builtin_fma(-kq, 2.4492935982947064e-16, rr);
        const double r2 = rr * rr; double sn = 1.0, cs = 1.0;
#pragma unroll 1
        for (int n = 13; n >= 1; --n) { sn = 1.0 - sn * r2 / (double)((2 * n) * (2 * n + 1)); cs = 1.0 - cs * r2 / (double)((2 * n - 1) * (2 * n)); }
        sn *= rr;
        float* o = (float*)(ws + WS_ROPE) + it * 2; o[0] = (float)cs; o[1] = (float)sn;
    }
    if (blockIdx.x == 0) {
        float v[DEPTH], mx = -1e30f;
#pragma unroll
        for (int l = 0; l < DEPTH; ++l) { v[l] = lb_logits[l * 512 + tid]; mx = fmaxf(mx, v[l]); }
        float s = 0.f;
#pragma unroll
        for (int l = 0; l < DEPTH; ++l) { v[l] = expf(v[l] - mx); s += v[l]; }
        float c = 0.f; float* lbo = (float*)(ws + WS_LB);
#pragma unroll
        for (int l = 0; l < DEPTH; ++l) { if (l > 0) c += v[l] / s; lbo[l * 512 + tid] = c; }
    }
    bf16_t* xb = (bf16_t*)(ws + WS_XB); float* ssq = (float*)(ws + WS_SSQM);
    for (int m = gw; m < M; m += 2 * NGW) {
        const bool has1 = (m + NGW) < M; const int m1 = has1 ? m + NGW : m;
        const f32x4* xr0 = (const f32x4*)(x + (size_t)m * D) + lane; const f32x4* xr1 = (const f32x4*)(x + (size_t)m1 * D) + lane; f32x4 v0[4], v1[4]; float s0 = 0.f, s1 = 0.f;
#pragma unroll
        for (int j = 0; j < 4; ++j) { v0[j] = xr0[64 * j]; v1[j] = xr1[64 * j]; }
#pragma unroll
        for (int j = 0; j < 4; ++j) { s0 += (v0[j][0] * v0[j][0] + v0[j][1] * v0[j][1]) + (v0[j][2] * v0[j][2] + v0[j][3] * v0[j][3]); s1 += (v1[j][0] * v1[j][0] + v1[j][1] * v1[j][1]) + (v1[j][2] * v1[j][2] + v1[j][3] * v1[j][3]); }
        s0 = wave_sum(s0); s1 = wave_sum(s1);
        u32x2* o0 = (u32x2*)(xb + (size_t)m * D) + lane; u32x2* o1 = (u32x2*)(xb + (size_t)m1 * D) + lane;
#pragma unroll
        for (int j = 0; j < 4; ++j) { u32x2 w; w.x = pk2(v0[j][0], v0[j][1]); w.y = pk2(v0[j][2], v0[j][3]); o0[64 * j] = w; }
        if (lane < 16) ssq[((size_t)(lane >> 2) * M + m) * 4 + (lane & 3)] = (lane == 0) ? s0 : 0.f;
        if (has1) {
#pragma unroll
            for (int j = 0; j < 4; ++j) { u32x2 w; w.x = pk2(v1[j][0], v1[j][1]); w.y = pk2(v1[j][2], v1[j][3]); o1[64 * j] = w; }
            if (lane < 16) ssq[((size_t)(lane >> 2) * M + m1) * 4 + (lane & 3)] = (lane == 0) ? s1 : 0.f; }
    }
}

__device__ __forceinline__ void ph_final(const Params& P) {
    int tid = tid_(); asm volatile("" : "+v"(tid));
    const int lane = tid & 63, wave = tid >> 6; const int gw = blockIdx.x * 8 + wave, NGW = gridDim.x * 8;
    const float* ssq = (const float*)(P.ws + WS_SSQM); const float* nf = P.in[16]; const bf16_t* xb = (const bf16_t*)(P.ws + WS_XB);
    f32x4 wv[4];
#pragma unroll
    for (int j = 0; j < 4; ++j) wv[j] = ((const f32x4*)nf)[lane + 64 * j];
    for (int m = gw; m < M; m += 2 * NGW) {
        const bool has1 = (m + NGW) < M; const int m1 = has1 ? m + NGW : m;
        const u32x2* xr0 = (const u32x2*)(xb + (size_t)m * D) + lane; const u32x2* xr1 = (const u32x2*)(xb + (size_t)m1 * D) + lane;
        u32x2 w0[4], w1[4];
#pragma unroll
        for (int j = 0; j < 4; ++j) { w0[j] = xr0[64 * j]; w1[j] = xr1[64 * j]; }
        const float rs0 = __builtin_amdgcn_rsqf(ssq_row(ssq + (size_t)m * 4) * (1.0f / 1024.0f) + NORM_EPS), rs1 = __builtin_amdgcn_rsqf(ssq_row(ssq + (size_t)m1 * 4) * (1.0f / 1024.0f) + NORM_EPS);
        f32x4* o0 = (f32x4*)(P.out + (size_t)m * D) + lane; f32x4* o1 = (f32x4*)(P.out + (size_t)m1 * D) + lane;
#pragma unroll
        for (int j = 0; j < 4; ++j) { f32x4 v = {bf_lo(w0[j].x), bf_hi(w0[j].x), bf_lo(w0[j].y), bf_hi(w0[j].y)}; v = v * rs0 * wv[j]; o0[64 * j] = v; }
#pragma unroll
        for (int j = 0; j < 4; ++j) { f32x4 v = {bf_lo(w1[j].x), bf_hi(w1[j].x), bf_lo(w1[j].y), bf_hi(w1[j].y)}; v = v * rs1 * wv[j]; if (has1) o1[64 * j] = v; } }
}

struct ScanArgs {
    const bf16_t* q; const bf16_t* k; const bf16_t* lg; const bf16_t* v; const bf16_t* og;
    int ldqk, qkcol, vcol; size_t row0; const float* gn; bf16_t* o; int ocol; int hidx; int sl; float* state; float* elp; const float* dec; int gch0;
};

template <int NC> __device__ __forceinline__ unsigned img_off(unsigned row, unsigned ch) { return (512u * NC) * (row >> 3) + 512u * (ch >> 2) + 64u * (row & 7) + 16u * ((ch & 3) ^ ((row >> 2) & 3)); }
template <int NC> struct FragBase { unsigned rowb[2], trb[2];
    __device__ __forceinline__ void init(int lane) { const unsigned h = lane >> 5, l31 = lane & 31, blk = (lane >> 4) & 1, q = (lane & 15) >> 2, p = lane & 3;
        rowb[0] = img_off<NC>(l31, h); rowb[1] = img_off<NC>(l31, 2 + h);
        trb[0] = img_off<NC>(8 * h + q, 2 * blk + (p >> 1)) + 8 * (p & 1); trb[1] = img_off<NC>(8 * h + 4 + q, 2 * blk + (p >> 1)) + 8 * (p & 1) - 256; } };
template <int NC> __device__ __forceinline__ bf16x8 row_frag(const LAS unsigned char* img, const FragBase<NC>& fb, int rbase, int s) { return *(const LAS bf16x8*)(img + fb.rowb[s & 1] + 512 * (s >> 1) + 512 * NC * (rbase >> 3)); }
template <int NC> __device__ __forceinline__ bf16x8 tr_frag(const LAS unsigned char* img, const FragBase<NC>& fb, int c, int ks) {
    const s16x4 lo = __builtin_bit_cast(s16x4, __builtin_amdgcn_ds_read_tr16_b64_v4i16((LAS s16x4*)(img + fb.trb[0] + 1024 * NC * ks + 512 * c)));
    const s16x4 hi = __builtin_bit_cast(s16x4, __builtin_amdgcn_ds_read_tr16_b64_v4i16((LAS s16x4*)(img + fb.trb[1] + 1024 * NC * ks + 512 * c + 256)));
    return (bf16x8){lo[0], lo[1], lo[2], lo[3], hi[0], hi[1], hi[2], hi[3]};
}
#define MFMA32(a, b, c) __builtin_amdgcn_mfma_f32_32x32x16_bf16((a), (b), (c), 0, 0, 0)

template <int DK, int MODE  , int ABL = 0>
__device__ __forceinline__ void scan_unit(LAS unsigned char* lds, const ScanArgs a) {
    constexpr int NC = DK / 32, NT = DK / 64;
    constexpr bool GATED = (MODE == 2);
    constexpr int NQ = DK / 64;
    constexpr int NCP = DK / 2, RG = 512 / NCP, RPG = 64 / RG;
    constexpr int NCH = SSL / 64;
    LAS unsigned char* ST = lds + 106496; LAS unsigned char* OT = lds + 139264; LAS unsigned char* PPs = lds + 98304;
    LAS float* RED = (LAS float*)(lds + 156160); LAS float* FV = (LAS float*)(lds + 158208); LAS float* ELP = (LAS float*)(lds + 158720); LAS float* TOT = (LAS float*)(lds + 159232);
    int tid = tid_(); asm volatile("" : "+v"(tid));
    const int lane = tid & 63, wave = __builtin_amdgcn_readfirstlane(tid >> 6), hh = lane >> 5, l31 = lane & 31;
    const int ib = wave >> 2, nb = wave & 3;
    FragBase<NC> fbk; fbk.init(lane); FragBase<4> fb4; fb4.init(lane); FragBase<2> fb2; fb2.init(lane);
    const int cp = tid % NCP, rg = tid / NCP;
    const int vrow = tid >> 3, vch = (tid & 7) * 2;
    const int pcl = tid & 3, prow = 2 * ((tid >> 3) & 31) + ((tid >> 2) & 1), phi = tid >> 8;
    f32x16 Sacc[NT];
#pragma unroll
    for (int t = 0; t < NT; ++t)
#pragma unroll
        for (int r = 0; r < 16; ++r) Sacc[t][r] = 0.f;
    if (a.sl > 0) {
#pragma unroll
        for (int t = 0; t < NT; ++t)
#pragma unroll
            for (int r = 0; r < 16; ++r) Sacc[t][r] = a.state[(t * 16 + r) * 512 + tid]; }
    if (tid < DK) { if (GATED) ELP[tid] = (a.sl > 0) ? a.elp[tid] : 1.0f; else if (MODE == 1) { int hx_ = a.hidx; asm volatile("" : "+s"(hx_)); FV[tid] = exp2f(64.0f * lg2gamma(hx_)); } }
    __syncthreads();
    unsigned rq[GATED ? RPG : 1], rk[GATED ? RPG : 1], rl[GATED ? RPG : 1]; u32x4 rq4[NQ], rk4[NQ]; float fve = 1.0f, fvl = 1.0f;     u32x4 rv[2]; u32x4 rog[2]; float cb0[GATED ? RPG : 1], cb1[GATED ? RPG : 1];
#define SC_LOAD_RAW(c_) do { const size_t r0_ = a.row0 + (size_t)(c_) * 64; \
        if (GATED) { _Pragma("unroll") for (int rr = 0; rr < RPG; ++rr) { const size_t ro_ = (r0_ + rg * RPG + rr) * a.ldqk + a.qkcol + 2 * cp; \
                rq[rr] = *(const unsigned*)(a.q + ro_); rk[rr] = *(const unsigned*)(a.k + ro_); } } \
        else { _Pragma("unroll") for (int i = 0; i < NQ; ++i) { const size_t ro_ = (r0_ + prow) * a.ldqk + a.qkcol + (pcl + 4 * (phi * NQ + i)) * 8; rq4[i] = *(const u32x4*)(a.q + ro_); rk4[i] = *(const u32x4*)(a.k + ro_); } \
            if (MODE == 3) { if (tid < DK) { const int gc_ = a.gch0 + (c_); const float e_ = a.dec[((size_t)gc_ * 4 + a.hidx) * 128 + tid]; \
                    const float l_ = ((gc_ & 63) > 0) ? a.dec[(size_t)1024 * 4 * 128 + ((size_t)(gc_ - 1) * 4 + a.hidx) * 128 + tid] : 1.0f; fve = e_; fvl = l_; } } } \
        _Pragma("unroll") for (int i = 0; i < 2; ++i) rv[i] = *(const u32x4*)(a.v + (r0_ + prow) * 512 + a.vcol + (pcl + 4 * (phi * 2 + i)) * 8); } while (0)
#define SC_LOAD_G(c_) do { if (GATED) { const size_t r0_ = a.row0 + (size_t)(c_) * 64; \
        _Pragma("unroll") for (int rr = 0; rr < RPG; ++rr) rl[rr] = *(const unsigned*)(a.lg + (r0_ + rg * RPG + rr) * a.ldqk + a.qkcol + 2 * cp); } } while (0)
#define SC_PREP1() do { if (GATED) { float s0 = 0.f, s1 = 0.f; \
        _Pragma("unroll") for (int rr = 0; rr < RPG; ++rr) { s0 += h_lo(rl[rr]); s1 += h_hi(rl[rr]); cb0[rr] = s0; cb1[rr] = s1; } \
        *(LAS f32x2*)(TOT + rg * DK + 2 * cp) = (f32x2){s0, s1}; } } while (0)
#define SC_PREP(b_) do { LAS unsigned char* QT_ = lds + (b_) * 49152; LAS unsigned char* KH_ = QT_ + 16384; LAS unsigned char* VV_ = QT_ + 32768; \
        if (GATED) { float o0 = 0.f, o1 = 0.f, r0 = 0.f, r1 = 0.f, t0 = 0.f, t1 = 0.f; \
            _Pragma("unroll") for (int g = 0; g < RG; ++g) { const f32x2 t = *(const LAS f32x2*)(TOT + g * DK + 2 * cp); if (g < rg) { o0 += t.x; o1 += t.y; } if (g < RG / 2) { r0 += t.x; r1 += t.y; } t0 += t.x; t1 += t.y; } \
            _Pragma("unroll") for (int hb_ = 0; hb_ < RPG; hb_ += 4) { float x0_[4], x1_[4], eq0_[4], eq1_[4], ek0_[4], ek1_[4]; \
            _Pragma("unroll") for (int rr = 0; rr < 4; ++rr) { x0_[rr] = (cb0[hb_ + rr] + o0 - r0) * 1.4426950408889634f; x1_[rr] = (cb1[hb_ + rr] + o1 - r1) * 1.4426950408889634f; } \
            SCHED_FENCE(); \
            _Pragma("unroll") for (int rr = 0; rr < 4; ++rr) { eq0_[rr] = __builtin_amdgcn_exp2f(x0_[rr]); eq1_[rr] = __builtin_amdgcn_exp2f(x1_[rr]); ek0_[rr] = __builtin_amdgcn_exp2f(-x0_[rr]); ek1_[rr] = __builtin_amdgcn_exp2f(-x1_[rr]); } \
            SCHED_FENCE(); \
            _Pragma("unroll") for (int rr = 0; rr < 4; ++rr) { const int row = rg * RPG + hb_ + rr; const unsigned ad = img_off<NC>(row, cp >> 2) + (cp & 3) * 4; \
                *(LAS unsigned*)(QT_ + ad) = cvt_pk_bf16(eq0_[rr] * bf_lo(rq[hb_ + rr]), eq1_[rr] * bf_hi(rq[hb_ + rr])); *(LAS unsigned*)(KH_ + ad) = cvt_pk_bf16(ek0_[rr] * bf_lo(rk[hb_ + rr]), ek1_[rr] * bf_hi(rk[hb_ + rr])); } \
            SCHED_FENCE(); } \
            if (rg == 0) { const f32x2 ep = *(const LAS f32x2*)(ELP + 2 * cp); *(LAS f32x2*)(FV + 2 * cp) = (f32x2){ep.x * exp_(r0), ep.y * exp_(r1)}; *(LAS f32x2*)(ELP + 2 * cp) = (f32x2){exp_(t0 - r0), exp_(t1 - r1)}; } \
        } else { _Pragma("unroll") for (int i = 0; i < NQ; ++i) { const unsigned ad = img_off<NC>(prow, pcl + 4 * (phi * NQ + i)); *(LAS u32x4*)(QT_ + ad) = rq4[i]; *(LAS u32x4*)(KH_ + ad) = rk4[i]; } if (MODE == 3) { if (tid < DK) FV[tid] = fve * fvl; } } \
        _Pragma("unroll") for (int i = 0; i < 2; ++i) *(LAS u32x4*)(VV_ + img_off<4>(prow, pcl + 4 * (phi * 2 + i))) = rv[i]; } while (0)
#define SC_STATE_IMG() do { _Pragma("unroll") for (int t = 0; t < NT; ++t) { const int kb = NT * (wave >> 2) + t; \
            _Pragma("unroll") for (int q4 = 0; q4 < 4; ++q4) { const f32x4 fv = *(const LAS f32x4*)(FV + 32 * kb + 8 * q4 + 4 * hh); \
                _Pragma("unroll") for (int e = 0; e < 4; ++e) Sacc[t][4 * q4 + e] *= fv[e]; \
                u32x2 w; w.x = cvt_pk_bf16(Sacc[t][4 * q4], Sacc[t][4 * q4 + 1]); w.y = cvt_pk_bf16(Sacc[t][4 * q4 + 2], Sacc[t][4 * q4 + 3]); \
                *(LAS u32x2*)(ST + img_off<NC>(32 * nb + l31, 4 * kb + q4) + 8 * hh) = w; } } } while (0)
#define SC_PTILES(b_) do { if (wave < 3) { const LAS unsigned char* QT_ = lds + (b_) * 49152; const LAS unsigned char* KH_ = QT_ + 16384; LAS unsigned char* PP_ = PPs; \
            const int jb = (wave == 2) ? 1 : 0, pib = (wave == 0) ? 0 : 1; f32x16 pt; \
            _Pragma("unroll") for (int r = 0; r < 16; ++r) pt[r] = 0.f; \
            _Pragma("unroll") for (int s = 0; s < DK / 16; ++s) pt = MFMA32(row_frag<NC>(KH_, fbk, 32 * jb, s), row_frag<NC>(QT_, fbk, 32 * pib, s), pt); \
            const int ig = 32 * pib + l31; \
            _Pragma("unroll") for (int q4 = 0; q4 < 4; ++q4) { const int j0 = 32 * jb + 8 * q4 + 4 * hh; float pv[4]; \
                _Pragma("unroll") for (int e = 0; e < 4; ++e) pv[e] = (j0 + e <= ig) ? pt[4 * q4 + e] : 0.f; \
                u32x2 w; w.x = cvt_pk_bf16(pv[0], pv[1]); w.y = cvt_pk_bf16(pv[2], pv[3]); \
                *(LAS u32x2*)(PP_ + img_off<2>(ig, 4 * jb + q4) + 8 * hh) = w; } } } while (0)

#define SC_OUT_PASS(c_) do { const size_t ro_ = (a.row0 + (size_t)(c_) * 64 + vrow) * 1536 + a.ocol + vch * 8; \
        _Pragma("unroll") for (int i = 0; i < 2; ++i) { const u32x2 y0_ = *(const LAS u32x2*)(OT + vrow * 264 + (vch + i) * 16), y1_ = *(const LAS u32x2*)(OT + vrow * 264 + (vch + i) * 16 + 8); const u32x4 yv = {y0_.x, y0_.y, y1_.x, y1_.y}; const u32x4 gv = rog[i]; u32x4 w; \
            w.x = cvt_pk_bf16(bf_lo(yv.x) * bf_lo(gv.x), bf_hi(yv.x) * bf_hi(gv.x)); w.y = cvt_pk_bf16(bf_lo(yv.y) * bf_lo(gv.y), bf_hi(yv.y) * bf_hi(gv.y)); \
            w.z = cvt_pk_bf16(bf_lo(yv.z) * bf_lo(gv.z), bf_hi(yv.z) * bf_hi(gv.z)); w.w = cvt_pk_bf16(bf_lo(yv.w) * bf_lo(gv.w), bf_hi(yv.w) * bf_hi(gv.w)); \
            if (!(ABL & 16)) *(u32x4*)(a.o + ro_ + i * 8) = w; else asm volatile("" :: "v"(w)); } } while (0)
#define SC_LOAD_OG(c_) do { const size_t ro_ = (a.row0 + (size_t)(c_) * 64 + vrow) * 512 + a.vcol + vch * 8; \
        _Pragma("unroll") for (int i = 0; i < 2; ++i) rog[i] = *(const u32x4*)(a.og + ro_ + i * 8); } while (0)
    SC_LOAD_G(0); SC_LOAD_RAW(0);
    SC_PREP1();
    __syncthreads();
    SC_PREP(0);
    SC_LOAD_G(1); SC_LOAD_RAW(1);
    __syncthreads();
    SC_STATE_IMG();
    SC_PTILES(0);
    SC_PREP1();
    SC_LOAD_G(2);
    __syncthreads();
    for (int c = 0; c < NCH; ++c) {
        const int bc = c & 1, bn = bc ^ 1;
        const LAS unsigned char* QT = lds + bc * 49152; const LAS unsigned char* KH = QT + 16384; const LAS unsigned char* VV = QT + 32768; const LAS unsigned char* PP = PPs;
        if (c > 0) SC_OUT_PASS(c - 1);
        SC_LOAD_OG(c);
        f32x16 ot;
#pragma unroll
        for (int r = 0; r < 16; ++r) ot[r] = 0.f;
        if (!(ABL & 2)) {
#pragma unroll
        for (int s = 0; s < DK / 16; ++s) ot = MFMA32(row_frag<NC>(ST, fbk, 32 * nb, s), row_frag<NC>(QT, fbk, 32 * ib, s), ot); }
        bf16x8 vf[4];
#pragma unroll
        for (int s = 0; s < 4; ++s) vf[s] = tr_frag<4>(VV, fb4, nb, s);
        if (!(ABL & 2)) {
#pragma unroll
        for (int s = 0; s < 4; ++s) if (s < 2 || ib == 1) ot = MFMA32(vf[s], row_frag<2>(PP, fb2, 32 * ib, s), ot); }
        if (!(ABL & 4)) {
#pragma unroll
        for (int t = 0; t < NT; ++t) { const int kb = NT * (wave >> 2) + t;
#pragma unroll
            for (int s = 0; s < 4; ++s) Sacc[t] = MFMA32(tr_frag<NC>(KH, fbk, kb, s), vf[s], Sacc[t]); } }
        else { asm volatile("" :: "v"(vf[0]), "v"(vf[1]), "v"(vf[2]), "v"(vf[3])); }
        if (!(ABL & 1)) { SC_PREP(bn); } else { if (GATED) { asm volatile("" :: "v"(rq[0]), "v"(rk[0]), "v"(rq[RPG - 1]), "v"(rk[RPG - 1])); } else { asm volatile("" :: "v"(rq4[0]), "v"(rk4[0])); } asm volatile("" :: "v"(rv[0]), "v"(rv[1])); }
        { float ss = 0.f, sm = 0.f;
#pragma unroll
            for (int r = 0; r < 16; ++r) { ss += ot[r] * ot[r]; sm += ot[r]; }
            ss = xsum32(ss); sm = xsum32(sm);
            if (hh == 0) *(LAS f32x2*)(RED + ((32 * ib + l31) * 4 + nb) * 2) = (f32x2){ss, sm}; }
        __syncthreads();
        SC_LOAD_RAW(c + 2 < NCH ? c + 2 : NCH - 1);
        { const LAS f32x4* rp = (const LAS f32x4*)(RED + (32 * ib + l31) * 8); const f32x4 r0 = rp[0], r1 = rp[1];
            const float ss = (r0[0] + r0[2]) + (r1[0] + r1[2]), sm = (r0[1] + r0[3]) + (r1[1] + r1[3]);
            float mu = 0.f, rs;
            if (MODE == 1) { mu = sm * (1.0f / 128.0f); rs = __builtin_amdgcn_rsqf(ss * (1.0f / 128.0f) - mu * mu + NORM_EPS); }
            else rs = __builtin_amdgcn_rsqf(ss * (1.0f / 128.0f) + NORM_EPS);
#pragma unroll
            for (int q4 = 0; q4 < 4; ++q4) { float y[4];
#pragma unroll
                for (int e = 0; e < 4; ++e) y[e] = (ot[4 * q4 + e] - mu) * rs;
                u32x2 w; w.x = cvt_pk_bf16(y[0], y[1]); w.y = cvt_pk_bf16(y[2], y[3]);
                *(LAS u32x2*)(OT + (32 * ib + l31) * 264 + (32 * nb + 8 * q4 + 4 * hh) * 2) = w; } }
        if (c + 1 < NCH) { SC_STATE_IMG(); if (!(ABL & 8)) { SC_PTILES(bn); } }
        if (!(ABL & 1)) { SC_PREP1(); } else if (GATED) { asm volatile("" :: "v"(rl[0]), "v"(rl[RPG - 1])); }
        SC_LOAD_G(c + 3 < NCH ? c + 3 : NCH - 1);
        __syncthreads();
    }
    SC_OUT_PASS(NCH - 1);
#undef SC_OUT_PASS
#undef SC_LOAD_OG
#undef SC_LOAD_RAW
#undef SC_LOAD_G
#undef SC_PREP1
#undef SC_PREP
#undef SC_STATE_IMG
#undef SC_PTILES
    if (a.sl + 1 < NSL) {
#pragma unroll
        for (int t = 0; t < NT; ++t)
#pragma unroll
            for (int r = 0; r < 16; ++r) a.state[(t * 16 + r) * 512 + tid] = Sacc[t][r];
        if (GATED && tid < DK) a.elp[tid] = ELP[tid]; }
}

__device__ __forceinline__ void inproj_setup(const Params& P, int l, LAS unsigned char* lds) {
    int t_ = tid_(); asm volatile("" : "+v"(t_));
    if (t_ == 0) *(LAS int*)(lds + RSTD_OFF + 1024) = -1;
    if (t_ < 128) ((LAS f32x4*)(lds + LBV_OFF))[t_] = ((const f32x4*)((const float*)(P.ws + WS_LB) + l * 512))[t_];
    else if (t_ < 192) ((LAS f32x4*)(lds + BGK_OFF))[t_ - 128] = ((const f32x4*)(P.in[5] + l * 256))[t_ - 128];
    __syncthreads();
}
constexpr int NDEF = 3;
__device__ __forceinline__ void ph_scan(const Params& P, int l, int sl, LAS unsigned char* lds) {
    const int u = blockIdx.x, NSC = 3 * NBATCH * 4;
    if (u >= NBATCH * 4) {
        pg8::ListOrder S;
        if (u >= NSC) S = pg8::ListOrder{u - NSC, (int)gridDim.x - NSC, 2, 4, PN / 256 - NDEF};
        else          S = pg8::ListOrder{u - NBATCH * 4, 0, 1, 1, PN / 256 - 1};
        inproj_setup(P, l, lds);
        pg8::Gemm g{(const bf16_t*)(P.ws + WS_XB), (const bf16_t*)(P.ws + WS_WIN + l * WIN_L), MS, PN, D, D, 1, sl};
        EpiInProj E{(const float*)(P.ws + WS_SSQM), (const float*)(P.ws + WS_LB) + l * 512, P.in[5] + l * 256, (const float*)(P.ws + WS_ROPE), (bf16_t*)(P.ws + WS_PROJ), sl, lds, (float*)(P.ws + WS_DEC)};
        pg8::gemm_phase<EpiInProj, pg8::ListOrder>(lds, g, S, E);
        if (u >= NSC) return;
        __syncthreads();
    }
    const int mix = u / (NBATCH * 4), bl = (u % (NBATCH * 4)) / 4, h = u % 4;
    const bf16_t* pb = (const bf16_t*)(P.ws + WS_PROJ);
    ScanArgs a; a.sl = sl; a.state = (float*)(P.ws + WS_STATE) + (size_t)u * 16384; a.elp = (float*)(P.ws + WS_ELP) + u * 128; a.row0 = (size_t)bl * SSL; a.o = (bf16_t*)(P.ws + WS_O); a.ocol = mix * 512 + h * 128; a.vcol = h * 128; a.hidx = h; a.gn = nullptr; a.lg = nullptr; a.dec = (const float*)(P.ws + WS_DEC); a.gch0 = bl * 64 + sl * (SSL / 64);
    if (mix == 0) { a.q = pb + PO_AQ; a.k = pb + PO_AK; a.v = pb + PO_AV; a.og = pb + PO_AOG; a.ldqk = 512; a.qkcol = h * 128; scan_unit<128, 3>(lds, a); }
    else if (mix == 1) { a.q = pb + PO_BQ; a.k = pb + PO_BK; a.v = pb + PO_BV; a.og = pb + PO_BOG; a.ldqk = 256; a.qkcol = h * 64; scan_unit<64, 1>(lds, a); }
    else { a.q = pb + PO_CQ; a.k = pb + PO_CK; a.lg = pb + PO_CLG; a.v = pb + PO_CV; a.og = pb + PO_COG; a.ldqk = 256; a.qkcol = h * 64; a.gn = P.in[7] + l * 128; scan_unit<64, 2>(lds, a); }
}

__device__ __forceinline__ void zero_f32(float* p, int n) { int t_ = tid_(); asm volatile("" : "+v"(t_)); for (int i = blockIdx.x * 512 + t_; i < n; i += gridDim.x * 512) p[i] = 0.f; }

__device__ __forceinline__ void ph_inproj(const Params& P, int l, int sl, LAS unsigned char* lds) {
    inproj_setup(P, l, lds);
    pg8::Gemm g{(const bf16_t*)(P.ws + WS_XB), (const bf16_t*)(P.ws + WS_WIN + l * WIN_L), MS, PN, D, D, 1, sl};
    pg8::StaticOrder S; S.init(MS, PN - 3 * 256, gridDim.x, blockIdx.x);
    EpiInProj E{(const float*)(P.ws + WS_SSQM), (const float*)(P.ws + WS_LB) + l * 512, P.in[5] + l * 256, (const float*)(P.ws + WS_ROPE), (bf16_t*)(P.ws + WS_PROJ), sl, lds, (float*)(P.ws + WS_DEC)};
    pg8::gemm_phase<EpiInProj, pg8::StaticOrder>(lds, g, S, E);
}
__device__ __forceinline__ void ph_branch(const Params& P, int l, int sl, LAS unsigned char* lds) {
    bf16_t* pb = (bf16_t*)(P.ws + WS_PROJ);
    pg8::Gemm g{(const bf16_t*)(P.ws + WS_O), (const bf16_t*)(P.ws + WS_WBR + l * WBR_L), MS, D, 1536, 1536, 0, 0};
    pg8::StaticOrder S; S.init(MS, D, gridDim.x, blockIdx.x);
    EpiGate E{(const unsigned char*)(pb + PO_MG), (bf16_t*)((unsigned char*)P.out + DO_GP)};
    pg8::gemm_phase<EpiGate, pg8::StaticOrder>(lds, g, S, E);
    (void)sl;
}
__device__ __forceinline__ void ph_outproj(const Params& P, int l, int sl, LAS unsigned char* lds) {
    const bf16_t* pb = (const bf16_t*)(P.ws + WS_PROJ);
    pg8::Gemm g{(const bf16_t*)((const unsigned char*)P.out + DO_GP), (const bf16_t*)(P.ws + WS_WOUT + l * WOUT_L), MS, D, D, D, 0, 0};
    pg8::StaticOrder S; S.init(MS, D, gridDim.x, blockIdx.x);
    EpiResid E{(bf16_t*)(P.ws + WS_XB), (float*)(P.ws + WS_SSQF), sl};
    pg8::gemm_phase<EpiResid, pg8::StaticOrder>(lds, g, S, E);
}
__device__ __forceinline__ void ph_ffn1(const Params& P, int l, int sl, LAS unsigned char* lds) {
    if (tid_() == 0) *(LAS int*)(lds + RSTD_OFF + 1024) = -1;
    __syncthreads();
    bf16_t* pb = (bf16_t*)(P.ws + WS_PROJ);
    pg8::Gemm g{(const bf16_t*)(P.ws + WS_XB), (const bf16_t*)(P.ws + WS_WGU + l * WGU_L), MS, GU, D, D, 1, sl};
    pg8::StaticOrder S; S.init(MS, GU, gridDim.x, blockIdx.x);
    EpiSwiGLU E{(const float*)(P.ws + WS_SSQF), (bf16_t*)((unsigned char*)P.out + DO_ACT), sl, lds};
    pg8::gemm_phase<EpiSwiGLU, pg8::StaticOrder>(lds, g, S, E);
}
__device__ __forceinline__ void ph_ffn2(const Params& P, int l, int sl, LAS unsigned char* lds) {
    const bf16_t* pb = (const bf16_t*)(P.ws + WS_PROJ);
    pg8::Gemm g{(const bf16_t*)((const unsigned char*)P.out + DO_ACT), (const bf16_t*)(P.ws + WS_WDN + l * WDN_L), MS, D, FF, FF, 0, 0};
    pg8::StaticOrder S; S.init(MS, D, gridDim.x, blockIdx.x);
    EpiResid E{(bf16_t*)(P.ws + WS_XB), (float*)(P.ws + WS_SSQM), sl};
    pg8::gemm_phase<EpiResid, pg8::StaticOrder>(lds, g, S, E);
}

__global__ void __launch_bounds__(512, 2) mega_fwd(Params P) {
    extern __shared__ __attribute__((aligned(16))) unsigned char lds_raw[];
    LAS unsigned char* lds = (LAS unsigned char*)lds_raw;
    volatile LAS unsigned* MISC = (volatile LAS unsigned*)(lds + MISC_OFF);
    { const int t0 = threadIdx.x;
        if ((t0 & 63) == 0) *(volatile LAS int*)(unsigned long)(WAVTAB_OFF + 4 * hw_slot_()) = t0 >> 6;
        if (t0 < 32) MISC[t0] = 0u; }
    __syncthreads();
    const int lo = P.ph_lo, hi = P.ph_hi;
    const bool multi = (hi - lo) > 1;
    XcdBarrier bar; bar.bar = (unsigned*)(P.ws + WS_CTL) + CW_BAR; bar.x = 0; bar.st = MISC + 8;
    if (multi) bar = xcd_barrier_post((unsigned*)(P.ws + WS_CTL) + CW_BAR, MISC + 8);
#ifndef PH_MASK
#define PH_MASK 0xFF
#endif
#define PHM(n) (((PH_MASK) >> (n)) & 1)
#define IN(k) (lo <= (k) && (k) < hi)
#define SEAM(k) do { if (IN((k) + 1)) { xcd_barrier(bar); } } while (0)
    if (PHM(0) && IN(0)) { ph_prologue(P, lds); __syncthreads(); SEAM(0); }
    for (int lh = 0; lh < DEPTH * NSL; ++lh) {
        const int l = lh / NSL, sl = lh % NSL, pb = 1 + 6 * lh;
        if (PHM(1) && IN(pb + 0)) { ph_inproj(P, l, sl, lds); SEAM(pb + 0); }
        if (PHM(2) && IN(pb + 1)) { ph_scan(P, l, sl, lds); __syncthreads(); __syncthreads(); SEAM(pb + 1); }
        if (PHM(3) && IN(pb + 2)) { ph_branch(P, l, sl, lds); SEAM(pb + 2); }
        if (PHM(4) && IN(pb + 3)) { ph_outproj(P, l, sl, lds); SEAM(pb + 3); }
        if (PHM(5) && IN(pb + 4)) { ph_ffn1(P, l, sl, lds); SEAM(pb + 4); }
        if (PHM(6) && IN(pb + 5)) { ph_ffn2(P, l, sl, lds); if (lh == DEPTH * NSL - 1) SEAM(pb + 5); else __syncthreads(); }
    }
    if (PHM(7) && IN(NPH - 1)) ph_final(P);
#undef IN
#undef SEAM
}

extern "C" void kernel_launch(void* const* d_in, const int* in_sizes, int n_in, void* d_out, int out_size, void* d_ws, size_t ws_size, hipStream_t stream) {
    static int grid = 0;
    if (grid == 0) {
        if (n_in != 17 || in_sizes[0] != M * D || out_size != M * D || ws_size < WS_END) { fprintf(stderr, "kernel_launch: unexpected shapes (n_in %d, in0 %d, out %d, ws %zu); nothing launched\n", n_in, n_in > 0 ? in_sizes[0] : -1, out_size, ws_size); grid = -1; return; }
        int dev = 0, cus = 0, per_cu = 0;
        if (hipGetDevice(&dev) != hipSuccess || hipDeviceGetAttribute(&cus, hipDeviceAttributeMultiprocessorCount, dev) != hipSuccess) { grid = -1; return; }
        if (hipFuncSetAttribute((const void*)mega_fwd, hipFuncAttributeMaxDynamicSharedMemorySize, LDS_BYTES) != hipSuccess) { fprintf(stderr, "kernel_launch: hipFuncSetAttribute failed\n"); grid = -1; return; }
        if (hipOccupancyMaxActiveBlocksPerMultiprocessor(&per_cu, (const void*)mega_fwd, 512, LDS_BYTES) != hipSuccess || per_cu < 1) { fprintf(stderr, "kernel_launch: occupancy query says %d\n", per_cu); }
        (void)hipGetLastError();
        grid = cus;
    }
    if (grid < 0) return;
    if (hipMemsetAsync((char*)d_ws + WS_CTL, 0, CTL_ZERO_BYTES, stream) != hipSuccess) return;
    Params p{};
    for (int i = 0; i < 17; ++i) p.in[i] = (const float*)d_in[i];
    p.out = (float*)d_out; p.ws = (unsigned char*)d_ws;
#if MK_N_LAUNCHES == 1
    p.ph_lo = 0; p.ph_hi = NPH;
    hipLaunchKernelGGL(mega_fwd, dim3(grid), dim3(512), LDS_BYTES, stream, p);
#else
    for (int k = 0; k < NPH; ++k) { p.ph_lo = k; p.ph_hi = k + 1; hipLaunchKernelGGL(mega_fwd, dim3(grid), dim3(512), LDS_BYTES, stream, p); }
#endif
}
```

```cpp
#include <hip/hip_runtime.h>
#include <cstdio>
#include <cstdint>

#ifndef MK_N_LAUNCHES
#define MK_N_LAUNCHES 1
#endif

#define LAS __attribute__((address_space(3)))
#define WAVTAB_OFF 163584
__device__ __forceinline__ int hw_slot_() { return (int)(__builtin_amdgcn_s_getreg(((6 - 1) << 11) | 4) & 0x3F); }
__device__ __forceinline__ int lane_() { int l; asm volatile("v_mbcnt_lo_u32_b32 %0, -1, 0\n\tv_mbcnt_hi_u32_b32 %0, -1, %0" : "=v"(l)); return l; }
__device__ __forceinline__ int tid_() { const int wv = *(const volatile LAS int*)(unsigned long)(WAVTAB_OFF + 4 * hw_slot_()); return (__builtin_amdgcn_readfirstlane(wv) << 6) | lane_(); }
#define GAS __attribute__((address_space(1)))

namespace pg8 {
#define PG8_LAS __attribute__((address_space(3)))
typedef unsigned short bf16_t;
typedef short bf16x8 __attribute__((ext_vector_type(8)));
typedef float f32x4 __attribute__((ext_vector_type(4)));
typedef unsigned u32x4 __attribute__((ext_vector_type(4)));
typedef unsigned u32x2 __attribute__((ext_vector_type(2)));
constexpr int BM = 256, BK = 64, HALF = 128, HTB = HALF * BK * 2, STAGE_BYTES = 8 * HTB, NXCD = 8, WGM = 8;

__host__ __device__ __forceinline__ int lds_byte(int r, int c) { const int st = (r >> 4) * 2 + (c >> 5), rr = r & 15, cc = c & 31, ob = rr * 64 + cc * 2; return st * 1024 + (ob ^ (((ob >> 9) & 1) << 5)); }
__host__ __device__ __forceinline__ void stage_rc(int b, int& R, int& C) { const int st = b / 1024, sb = b % 1024, swz = sb ^ (((sb >> 9) & 1) << 5); R = (st >> 1) * 16 + swz / 64; C = (st & 1) * 32 + (swz % 64) / 2; }
__host__ __device__ __forceinline__ int perm32(int rho) { const int n = rho >> 4, i = rho & 15; return 8 * (i >> 2) + 4 * n + (i & 3); }

struct Unit { int pm, pn; };
struct Gemm { const bf16_t* A; const bf16_t* Bt; int M, N, K, lda, amap, asl; };

struct StaticOrder {
    int nM, nN, nwg, G, c;
    __host__ __device__ void init(int M, int N, int G_, int c_) { nM = M / BM; nN = N / BM; nwg = nM * nN; G = G_; c = c_; }
    __host__ __device__ bool next(int i, Unit& u) const {
        const long L = (long)i * G + c; if (L >= nwg) return false;
        int wgid = (int)L; { const int q = nwg / NXCD, r = nwg % NXCD, xcd = wgid % NXCD, off = wgid / NXCD; wgid = (xcd < r ? xcd * (q + 1) : r * (q + 1) + (xcd - r) * q) + off; }
        const int nig = WGM * nN, gid = wgid / nig, fm = gid * WGM, gsz = (nM - fm) < WGM ? (nM - fm) : WGM;
        u.pm = fm + ((wgid % nig) % gsz); u.pn = (wgid % nig) / gsz; return true;
    }
};

struct ListOrder { int pm0, dpm, npn, count, pn0;
    __host__ __device__ bool next(int i, Unit& u) const { if (i >= count) return false; u.pm = pm0 + dpm * (i / npn); u.pn = pn0 + i % npn; return true; } };
struct TailOrder { int c, pn, nrow, nwg;
    __host__ __device__ bool next(int i, Unit& u) const { const int L = i * nwg + c; if (L >= nrow) return false; u.pm = L; u.pn = pn; return true; } };

__device__ __forceinline__ unsigned cvt_pk_bf16(float lo, float hi) { unsigned r; asm volatile("v_cvt_pk_bf16_f32 %0, %1, %2" : "=v"(r) : "v"(lo), "v"(hi)); return r; }

template <class Epi, class Sched>
__device__ __forceinline__ void gemm_phase(PG8_LAS unsigned char* lds, const Gemm g, const Sched& S, const Epi& E) {
    int tid = tid_(); asm volatile("" : "+v"(tid));
    const int wid = __builtin_amdgcn_readfirstlane(tid >> 6), lane = tid & 63, wr = wid >> 2, wc = wid & 3, fr = lane & 15, fq = lane >> 4;
    const int K = g.K, nt = K / BK, lda = g.lda;
    unsigned voffA[2], voffB[2];
#pragma unroll
    for (int i = 0; i < 2; ++i) { int R, C; stage_rc(tid * 16 + i * 8192, R, C); const int Rb = Epi::PERM ? ((R & ~31) + perm32(R & 31)) : R;
        voffA[i] = (unsigned)(R * lda + C) * 2u; voffB[i] = (unsigned)(Rb * K + C) * 2u; }
    const size_t kstep = (size_t)(BK * 2);
    const size_t hstepA = (size_t)HALF * lda * 2, hstepB = (size_t)HALF * K * 2;
    const size_t tstepA = 2 * hstepA, tstepB = 2 * hstepB;
    const unsigned ldsw = (unsigned)wid * 1024u;
    const int aoff = lds_byte(wr * 64 + fr, fq * 8), boff = lds_byte(wc * 32 + fr, fq * 8);
#define PG8_ABASE(u) ((const char*)g.A + (size_t)(g.amap ? ((((u).pm >> 3) << 4) + (g.asl << 3) + ((u).pm & 7)) : (u).pm) * tstepA)
#define PG8_BBASE(u) ((const char*)g.Bt + (size_t)(u).pn * tstepB)
#define PG8_SA(b, h) (((b) * 2 + (h)) * HTB)
#define PG8_SB(b, h) ((4 + (b) * 2 + (h)) * HTB)
#define PG8_STAGE(bufoff, gbase, voff) do { _Pragma("unroll") for (int _i = 0; _i < 2; ++_i) { unsigned vo_ = (voff)[_i]; asm volatile("" : "+v"(vo_));     \
        __builtin_amdgcn_global_load_lds((const unsigned*)((const char*)(gbase) + vo_), (PG8_LAS unsigned*)(lds + (bufoff) + ldsw + _i * 8192), 16, 0, 0); } } while (0)
#define PG8_LDA(dst, b, h) do { _Pragma("unroll") for (int m = 0; m < 4; ++m) _Pragma("unroll") for (int k = 0; k < 2; ++k) dst[m][k] = *(const PG8_LAS bf16x8*)(lds + PG8_SA(b, h) + aoff + m * 2048 + k * 1024); } while (0)
#define PG8_LDB(dst, b, h) do { _Pragma("unroll") for (int n = 0; n < 2; ++n) _Pragma("unroll") for (int k = 0; k < 2; ++k) dst[n][k] = *(const PG8_LAS bf16x8*)(lds + PG8_SB(b, h) + boff + n * 2048 + k * 1024); } while (0)
#define PG8_MMA(ai, bj, At, Bt) do { __builtin_amdgcn_s_setprio(1); _Pragma("unroll") for (int m = 0; m < 4; ++m) _Pragma("unroll") for (int n = 0; n < 2; ++n) _Pragma("unroll") for (int k = 0; k < 2; ++k) \
        acc[ai][bj][m][n] = __builtin_amdgcn_mfma_f32_16x16x32_bf16(Bt[n][k], At[m][k], acc[ai][bj][m][n], 0, 0, 0); __builtin_amdgcn_s_setprio(0); } while (0)
#define PG8_MMA0(ai, bj, At, Bt) do { __builtin_amdgcn_s_setprio(1); _Pragma("unroll") for (int m = 0; m < 4; ++m) _Pragma("unroll") for (int n = 0; n < 2; ++n) { \
        acc[ai][bj][m][n] = __builtin_amdgcn_mfma_f32_16x16x32_bf16(Bt[n][0], At[m][0], (f32x4){0.f, 0.f, 0.f, 0.f}, 0, 0, 0); \
        acc[ai][bj][m][n] = __builtin_amdgcn_mfma_f32_16x16x32_bf16(Bt[n][1], At[m][1], acc[ai][bj][m][n], 0, 0, 0); } __builtin_amdgcn_s_setprio(0); } while (0)
#define PG8_WAIT_V(n) asm volatile("s_waitcnt vmcnt(" #n ")" ::: "memory")
#define PG8_WAIT_L(n) asm volatile("s_waitcnt lgkmcnt(" #n ")" ::: "memory")
#define PG8_BAR __builtin_amdgcn_s_barrier()
#define PG8_SCHED __builtin_amdgcn_sched_barrier(0)
    Unit cur, nxt; int ui = 0;
    if (!S.next(0, cur)) return;
    f32x4 acc[2][2][4][2];
    bf16x8 At[4][2], B0[2][2], B1[2][2];
    const char* cA = PG8_ABASE(cur); const char* cB = PG8_BBASE(cur);
    int rsb = 0;
    PG8_STAGE(PG8_SB(0, 0), cB, voffB); PG8_STAGE(PG8_SB(0, 1), cB + hstepB, voffB); PG8_STAGE(PG8_SA(0, 0), cA, voffA); PG8_STAGE(PG8_SA(0, 1), cA + hstepA, voffA);
    if constexpr (Epi::RSTD) E.prep(cur.pm, 0);
    if (wr == 1) PG8_BAR;
    PG8_WAIT_V(2); PG8_BAR;
    PG8_STAGE(PG8_SB(1, 0), cB + kstep, voffB); PG8_STAGE(PG8_SA(1, 0), cA + kstep, voffA); PG8_STAGE(PG8_SB(1, 1), cB + hstepB + kstep, voffB);
    PG8_WAIT_V(6); PG8_BAR;
    for (;;) {
        const bool has_next = S.next(ui + 1, nxt);
        const char* nA = has_next ? PG8_ABASE(nxt) : cA; const char* nB = has_next ? PG8_BBASE(nxt) : cB;
#define PG8_ITER(T, FIRST) { const int t = (T); const bool last = (t == nt - 2); \
            const char* a1 = cA + (size_t)(t + 1) * kstep; \
            const char* a2 = last ? nA : cA + (size_t)(t + 2) * kstep; const char* b2 = last ? nB : cB + (size_t)(t + 2) * kstep; \
            const char* a3 = a2 + kstep; const char* b3 = b2 + kstep; \
            if constexpr (Epi::MID) { if (!(FIRST) && (t == 8 || t == 16)) E.mid(acc, cur, t, wr, wc, fr, fq); } \
              \
            PG8_LDB(B0, 0, 0); PG8_LDB(B1, 0, 1); PG8_SCHED; PG8_LDA(At, 0, 0); PG8_STAGE(PG8_SA(1, 1), a1 + hstepA, voffA); \
            PG8_WAIT_V(8); PG8_WAIT_L(0); PG8_BAR; if (FIRST) { PG8_MMA0(0, 0, At, B0); PG8_MMA0(0, 1, At, B1); } else { PG8_MMA(0, 0, At, B0); PG8_MMA(0, 1, At, B1); } PG8_BAR; PG8_SCHED; \
              \
            PG8_LDA(At, 0, 1); PG8_STAGE(PG8_SB(0, 0), b2, voffB); PG8_STAGE(PG8_SB(0, 1), b2 + hstepB, voffB); PG8_STAGE(PG8_SA(0, 0), a2, voffA); \
            PG8_WAIT_V(8); PG8_WAIT_L(0); PG8_BAR; if (FIRST) { PG8_MMA0(1, 0, At, B0); PG8_MMA0(1, 1, At, B1); } else { PG8_MMA(1, 0, At, B0); PG8_MMA(1, 1, At, B1); } PG8_BAR; PG8_SCHED; \
              \
            PG8_LDB(B0, 1, 0); PG8_LDB(B1, 1, 1); PG8_SCHED; PG8_LDA(At, 1, 0); PG8_STAGE(PG8_SA(0, 1), a2 + hstepA, voffA); \
            PG8_WAIT_V(8); PG8_WAIT_L(0); PG8_BAR; PG8_MMA(0, 0, At, B0); PG8_MMA(0, 1, At, B1); PG8_BAR; PG8_SCHED; \
              \
            PG8_LDA(At, 1, 1); PG8_STAGE(PG8_SB(1, 0), b3, voffB); PG8_STAGE(PG8_SB(1, 1), b3 + hstepB, voffB); PG8_STAGE(PG8_SA(1, 0), a3, voffA); \
            PG8_WAIT_V(8); PG8_WAIT_L(0); PG8_BAR; PG8_MMA(1, 0, At, B0); PG8_MMA(1, 1, At, B1); PG8_BAR; PG8_SCHED; }
        PG8_ITER(0, 1)
        for (int tt_ = 2; tt_ < nt; tt_ += 2) PG8_ITER(tt_, 0)
        if constexpr (Epi::ALIGN) { if (wr == 0) PG8_BAR; }
        E(acc, cur, wr, wc, fr, fq, rsb);
        if (!has_next) break;
        if constexpr (Epi::RSTD) { if (nxt.pm != cur.pm) { rsb ^= 1; E.prep(nxt.pm, rsb); } }
        cur = nxt; cA = nA; cB = nB; ++ui;
        if constexpr (Epi::ALIGN) { if (wr == 1) PG8_BAR; }
    }
    PG8_WAIT_V(0);
    if constexpr (!Epi::ALIGN) { if (wr == 0) PG8_BAR; }
    PG8_BAR;
#undef PG8_ABASE
#undef PG8_BBASE
#undef PG8_SA
#undef PG8_SB
#undef PG8_STAGE
#undef PG8_LDA
#undef PG8_LDB
#undef PG8_MMA
#undef PG8_WAIT_V
#undef PG8_ITER
#undef PG8_MMA0
#undef PG8_WAIT_L
#undef PG8_BAR
#undef PG8_SCHED
}
}

using pg8::bf16_t; using pg8::f32x4; using pg8::u32x4; using pg8::u32x2; using pg8::bf16x8; using pg8::cvt_pk_bf16;
typedef float f32x16 __attribute__((ext_vector_type(16)));
typedef short s16x4 __attribute__((ext_vector_type(4)));
typedef float f32x2 __attribute__((ext_vector_type(2)));

#define XB_TMO      128
#define XB_XCNT(j)  (256  + 64 * (j))
#define XB_XSUB(j)  (1280 + 64 * (j))
#define XB_XGEN(j)  (2304 + 64 * (j))
#define XB_TOP      3328
#define XB_TOPGEN   3392
#define XCD_BAR_WORDS 3456
#define XB_SPIN_CAP (1u << 18)

__device__ __forceinline__ unsigned xb_ld(unsigned* p)              { return __hip_atomic_load(p, __ATOMIC_RELAXED, __HIP_MEMORY_SCOPE_AGENT); }
__device__ __forceinline__ unsigned xb_add(unsigned* p, unsigned v) { return __hip_atomic_fetch_add(p, v, __ATOMIC_RELAXED, __HIP_MEMORY_SCOPE_AGENT); }
__device__ __forceinline__ unsigned xb_xcc_id() { return (unsigned)__builtin_amdgcn_s_getreg((3 << 11) | 20) & 0xFu; }
#define XB_SPIN(cond, bar) do { unsigned _sp = 0; while (cond) { __builtin_amdgcn_s_sleep(1); \
    if ((++_sp & 255u) == 0u) { if (xb_ld(&(bar)[XB_TMO])) break; if (_sp > XB_SPIN_CAP) { atomicAdd(&(bar)[XB_TMO], 1u); break; } } } } while (0)

struct XcdBarrier { unsigned* bar; unsigned x; volatile LAS unsigned* st; };

__device__ __forceinline__ XcdBarrier xcd_barrier_post(unsigned* bar, volatile LAS unsigned* st) {
    XcdBarrier b; b.bar = bar; b.x = xb_xcc_id(); b.st = st;
    if (tid_() == 0) (void)xb_add(&bar[XB_XCNT(b.x)], 1u);
    return b;
}
__device__ __forceinline__ void xcd_barrier_complete(unsigned* bar, unsigned x, unsigned& nloc, unsigned& nx) {
    const unsigned G = gridDim.x * gridDim.y * gridDim.z;
    unsigned sum, cnt, mine, sp = 0u;
    for (;;) {
        sum = 0u; cnt = 0u; mine = 0u;
#pragma unroll
        for (unsigned j = 0; j < 16; ++j) { const unsigned c = xb_ld(&bar[XB_XCNT(j)]); sum += c; cnt += (c > 0u) ? 1u : 0u; mine = (j == x) ? c : mine; }
        if (sum == G) break;
        __builtin_amdgcn_s_sleep(1);
        if ((++sp & 255u) == 0u) { if (xb_ld(&bar[XB_TMO])) break; if (sp > XB_SPIN_CAP) { atomicAdd(&bar[XB_TMO], 1u); break; } }
    }
    nloc = mine > 0u ? mine : 1u; nx = cnt > 0u ? cnt : 1u;
}
__device__ __forceinline__ void xcd_barrier(const XcdBarrier& b) {
    asm volatile("s_waitcnt vmcnt(0)" ::: "memory");
    __syncthreads();
    if (tid_() == 0) {
        unsigned* bar = b.bar;
        __builtin_amdgcn_s_waitcnt(0);
        unsigned nloc = b.st[0], nx = b.st[1];
        if (nloc == 0u) { xcd_barrier_complete(bar, b.x, nloc, nx); b.st[0] = nloc; b.st[1] = nx; }
        const unsigned old = xb_add(&bar[XB_XSUB(b.x)], 1u);
        const unsigned gen = old / nloc;
        if (old + 1u == (gen + 1u) * nloc) {
            __builtin_amdgcn_fence(__ATOMIC_RELEASE, "agent");
            asm volatile("s_waitcnt vmcnt(0)" ::: "memory");
            const unsigned og = xb_add(&bar[XB_TOP], 1u);
            const unsigned tg = og / nx;
            if (og + 1u == (tg + 1u) * nx) xb_add(&bar[XB_TOPGEN], 1u);
            else XB_SPIN(xb_ld(&bar[XB_TOPGEN]) == tg, bar);
            __builtin_amdgcn_fence(__ATOMIC_ACQUIRE, "agent");
            xb_add(&bar[XB_XGEN(b.x)], 1u);
            asm volatile("s_waitcnt vmcnt(0)" ::: "memory");
        } else {
            XB_SPIN(xb_ld(&bar[XB_XGEN(b.x)]) == gen, bar);
            __builtin_amdgcn_fence(__ATOMIC_ACQUIRE, "agent");
            asm volatile("s_waitcnt vmcnt(0)" ::: "memory");
        }
    }
    __syncthreads();
}

constexpr int D = 1024, NBATCH = 16, SEQ = 4096, DEPTH = 4;
constexpr int M = NBATCH * SEQ;
constexpr int NSL = 2;
constexpr int MS = M / NSL;
constexpr int SSL = SEQ / NSL;
constexpr int PW = 8208;
constexpr int PN = 8448;
constexpr int FF = 2816, GU = 2 * FF;
constexpr float NORM_EPS = 1e-6f;
constexpr int REFROW = 31;

constexpr size_t MiB = (size_t)1 << 20;
constexpr size_t WS_CTL = 0, CTL_ZERO_BYTES = 64 * 1024;
constexpr int CW_BAR = 4096;
constexpr size_t WS_ROPE = 1 * MiB;
constexpr size_t WS_LB = 2 * MiB;
constexpr size_t WS_SSQM = 860 * MiB + 96 * MiB;
constexpr size_t WS_SSQF = WS_SSQM + (size_t)M * 64;
constexpr size_t WS_WIN = 4 * MiB,  WIN_L  = (size_t)PN * D * 2;
constexpr size_t WS_WBR = 70 * MiB, WBR_L  = (size_t)1024 * 1536 * 2;
constexpr size_t WS_WOUT = 82 * MiB, WOUT_L = (size_t)1024 * 1024 * 2;
constexpr size_t WS_WGU = 106 * MiB, WGU_L = (size_t)GU * D * 2;
constexpr size_t WS_WDN = 150 * MiB, WDN_L = (size_t)D * FF * 2;
constexpr size_t WS_XB = 172 * MiB;
constexpr size_t WS_PROJ = 300 * MiB;
constexpr size_t WS_O = 860 * MiB;
constexpr size_t WS_STATE = 964 * MiB;
constexpr size_t WS_ELP = 976 * MiB;
constexpr size_t WS_DEC = 977 * MiB;
constexpr size_t WS_END = 981 * MiB;
static_assert(WS_WIN + DEPTH * WIN_L <= WS_WBR && WS_WBR + DEPTH * WBR_L <= WS_WOUT && WS_WOUT + DEPTH * WOUT_L <= WS_WGU && WS_WGU + DEPTH * WGU_L <= WS_WDN && WS_WDN + DEPTH * WDN_L <= WS_XB, "weights map");
static_assert(WS_SSQF + (size_t)M * 64 <= WS_STATE && WS_STATE + 192 * 65536 <= WS_ELP && WS_ELP + 192 * 512 <= WS_END, "misc map");
constexpr size_t PO_AQ = 0, PO_AK = (size_t)MS * 512, PO_ALG = (size_t)MS * 1024, PO_AV = (size_t)MS * 1536, PO_AOG = (size_t)MS * 2048;
constexpr size_t PO_BQ = (size_t)MS * 2560, PO_BK = PO_BQ + (size_t)MS * 256, PO_BV = PO_BK + (size_t)MS * 256, PO_BOG = PO_BV + (size_t)MS * 512;
constexpr size_t PO_CQ = PO_BOG + (size_t)MS * 512, PO_CK = PO_CQ + (size_t)MS * 256, PO_CV = PO_CK + (size_t)MS * 256, PO_COG = PO_CV + (size_t)MS * 512, PO_CLG = PO_COG + (size_t)MS * 512;
constexpr size_t PO_MG = PO_CLG + (size_t)MS * 256, PO_END = PO_MG + (size_t)MS * 3072;
static_assert(PO_END == (size_t)MS * 8960 && WS_PROJ + PO_END * 2 <= WS_O && WS_O + (size_t)MS * 1536 * 2 <= WS_SSQM, "proj map");
constexpr size_t DO_ACT = 0, DO_GP = (size_t)MS * FF * 2;
static_assert(DO_GP + (size_t)MS * D * 2 <= (size_t)M * D * 4, "d_out scratch map");

constexpr int RING_BYTES = 131072;
constexpr int LBV_OFF = 131072 + 2048, BGK_OFF = 131072 + 4096;
constexpr int RSTD_OFF = 131072;
constexpr int MISC_OFF = 163328;
constexpr int LDS_BYTES = 163840;
constexpr int NPH = 2 + DEPTH * NSL * 6;

struct Params {
    const float* in[17];
    float* out;
    unsigned char* ws;
    int ph_lo, ph_hi;
};

#define LDS_WAIT() asm volatile("s_waitcnt lgkmcnt(0)" ::: "memory")
__device__ __forceinline__ unsigned f2bf(float f) { unsigned u = __builtin_bit_cast(unsigned, f); return (u + 0x7fffu + ((u >> 16) & 1u)) >> 16; }
__device__ __forceinline__ unsigned pk2(float lo, float hi) { return f2bf(lo) | (f2bf(hi) << 16); }
__device__ __forceinline__ float bf_lo(unsigned w) { return __builtin_bit_cast(float, w << 16); }
__device__ __forceinline__ float bf_hi(unsigned w) { return __builtin_bit_cast(float, w & 0xffff0000u); }
__device__ __forceinline__ unsigned pk2h(float lo, float hi) { typedef _Float16 h2 __attribute__((ext_vector_type(2))); h2 v = {(_Float16)lo, (_Float16)hi}; return __builtin_bit_cast(unsigned, v); }
__device__ __forceinline__ float h_lo(unsigned w) { typedef _Float16 h2 __attribute__((ext_vector_type(2))); h2 v = __builtin_bit_cast(h2, w); return (float)v.x; }
__device__ __forceinline__ float h_hi(unsigned w) { typedef _Float16 h2 __attribute__((ext_vector_type(2))); h2 v = __builtin_bit_cast(h2, w); return (float)v.y; }
__device__ __forceinline__ float ex2_(float x) { return __builtin_amdgcn_exp2f(x); }
__device__ __forceinline__ float exp_(float x) { return __builtin_amdgcn_exp2f(x * 1.4426950408889634f); }
__device__ __forceinline__ float log_(float x) { return __builtin_amdgcn_logf(x) * 0.6931471805599453f; }
__device__ __forceinline__ float sigmoidf_(float x) { return __builtin_amdgcn_rcpf(1.0f + __builtin_amdgcn_exp2f(x * -1.4426950408889634f)); }
__device__ __forceinline__ unsigned q8_(float s) { return (unsigned)__builtin_amdgcn_fmed3f(s * 256.0f + 0.5f, 1.0f, 255.0f); }
__device__ __forceinline__ unsigned q8c_(float t) { return (unsigned)__builtin_amdgcn_fmed3f(t, 1.0f, 255.0f); }
__device__ __forceinline__ unsigned q8x4(float a, float b, float c, float d) { return q8_(a) | (q8_(b) << 8) | (q8_(c) << 16) | (q8_(d) << 24); }
__device__ __forceinline__ float ub0(unsigned w) { return (float)(w & 0xffu); }
__device__ __forceinline__ float ub1(unsigned w) { return (float)((w >> 8) & 0xffu); }
__device__ __forceinline__ float ub2(unsigned w) { return (float)((w >> 16) & 0xffu); }
__device__ __forceinline__ float ub3(unsigned w) { return (float)(w >> 24); }
#define SCHED_FENCE() __builtin_amdgcn_sched_barrier(0)
template <int N> __device__ __forceinline__ void sigmoidN(const float (&x)[N], float (&s)[N]) {
    float t[N];
#pragma unroll
    for (int j = 0; j < N; ++j) t[j] = x[j] * -1.4426950408889634f;
    SCHED_FENCE();
#pragma unroll
    for (int j = 0; j < N; ++j) t[j] = __builtin_amdgcn_exp2f(t[j]);
    SCHED_FENCE();
#pragma unroll
    for (int j = 0; j < N; ++j) t[j] = 1.0f + t[j];
    SCHED_FENCE();
#pragma unroll
    for (int j = 0; j < N; ++j) s[j] = __builtin_amdgcn_rcpf(t[j]);
    SCHED_FENCE();
}
template <int CTRL> __device__ __forceinline__ float dpp_f(float v) { return __builtin_bit_cast(float, __builtin_amdgcn_update_dpp(0, __builtin_bit_cast(int, v), CTRL, 0xF, 0xF, false)); }
__device__ __forceinline__ float xsum16(float v) { return v + __builtin_bit_cast(float, __builtin_amdgcn_ds_swizzle(__builtin_bit_cast(int, v), 0x401F)); }
__device__ __forceinline__ float xsum32(float v) { unsigned a = __builtin_bit_cast(unsigned, v), b = a;
    asm volatile("s_nop 1\n\tv_permlane32_swap_b32 %0, %1\n\ts_nop 1" : "+v"(a), "+v"(b)); return __builtin_bit_cast(float, a) + __builtin_bit_cast(float, b); }
__device__ __forceinline__ void halves32(float v, float& lo, float& hi) { unsigned a = __builtin_bit_cast(unsigned, v), b = a;
    asm volatile("s_nop 1\n\tv_permlane32_swap_b32 %0, %1\n\ts_nop 1" : "+v"(a), "+v"(b)); lo = __builtin_bit_cast(float, a); hi = __builtin_bit_cast(float, b); }
__device__ __forceinline__ float wave_sum(float v) {
    v += dpp_f<0xB1>(v); v += dpp_f<0x4E>(v); v += dpp_f<0x124>(v); v += dpp_f<0x128>(v);
    return xsum32(xsum16(v));
}
__device__ __forceinline__ float ssq_row(const float* p) { const f32x4 a = *(const f32x4*)p, b = *(const f32x4*)(p + (size_t)65536 * 4), c = *(const f32x4*)(p + (size_t)65536 * 8), d = *(const f32x4*)(p + (size_t)65536 * 12); return ((a[0] + a[1]) + (a[2] + a[3])) + ((b[0] + b[1]) + (b[2] + b[3])) + ((c[0] + c[1]) + (c[2] + c[3])) + ((d[0] + d[1]) + (d[2] + d[3])); }
__device__ __forceinline__ int grow_of_tile(int pm, int sl) { return ((((pm >> 3) << 4) + (sl << 3) + (pm & 7)) << 8); }
__device__ __forceinline__ float lg2gamma(int h) { return __log2f(1.0f - exp2f(-5.0f - (float)h)); }


constexpr int RSTD_BUF2 = 6144;
__device__ __forceinline__ void panel_rstd_fill(LAS unsigned char* lds, const float* ssq, int g0, int buf) {
    int t_ = tid_(); asm volatile("" : "+v"(t_));
    const int row = t_ >> 1, hp = t_ & 1;
    const float* p = ssq + ((size_t)(2 * hp) * M + g0 + row) * 4;
    const f32x4 a = *(const f32x4*)p, b = *(const f32x4*)(p + (size_t)M * 4);
    float s = ((a[0] + a[1]) + (a[2] + a[3])) + ((b[0] + b[1]) + (b[2] + b[3]));
    s += dpp_f<0xB1>(s);
    if (hp == 0) ((LAS float*)(lds + RSTD_OFF + buf * RSTD_BUF2))[row] = __builtin_amdgcn_rsqf(s * (1.0f / 1024.0f) + NORM_EPS);
}

struct EpiInProj {
    static constexpr bool PERM = true, AFTER_DRAIN = false, MID = false, ALIGN = true, RSTD = true;
    const float* ssq;
    const float* lb;
    const float* bgk;
    const float* rope;
    bf16_t* pb;
    int sl; LAS unsigned char* lds; float* dec;
    __device__ __forceinline__ void prep(int pm, int buf) const { panel_rstd_fill(lds, ssq, grow_of_tile(pm, sl), buf); }
    __device__ __forceinline__ void operator()(const f32x4 (&acc)[2][2][4][2], const pg8::Unit& u, int wr, int wc, int fr, int fq, int rsb) const {
        asm volatile("" : "+v"(fr), "+v"(fq));
        const int pn = u.pn;
        int type, ldc, cb; size_t off; float scale = 1.0f;
        if (pn < 4)       { type = 3; off = PO_AQ;  ldc = 512; cb = pn * 128; }
        else if (pn < 6)  { type = 0; off = PO_AV;  ldc = 512; cb = (pn - 4) * 256; }
        else if (pn < 8)  { type = 1; off = PO_AOG; ldc = 512; cb = (pn - 6) * 256; }
        else if (pn == 8) { type = 4; off = PO_BQ;  ldc = 256; cb = 0; }
        else if (pn == 9) { type = 5; off = PO_BK;  ldc = 256; cb = 0; }
        else if (pn < 12) { type = 0; off = PO_BV;  ldc = 512; cb = (pn - 10) * 256; }
        else if (pn < 14) { type = 1; off = PO_BOG; ldc = 512; cb = (pn - 12) * 256; }
        else if (pn == 14){ type = 0; off = PO_CQ;  ldc = 256; cb = 0; scale = 0.125f; }
        else if (pn == 15){ type = 0; off = PO_CK;  ldc = 256; cb = 0; }
        else if (pn < 18) { type = 0; off = PO_CV;  ldc = 512; cb = (pn - 16) * 256; }
        else if (pn < 20) { type = 1; off = PO_COG; ldc = 512; cb = (pn - 18) * 256; }
        else if (pn == 20){ type = 6; off = PO_CLG; ldc = 256; cb = 0; }
        else              { type = 2; off = PO_MG;  ldc = 0; cb = 0; }
        const int rl0 = u.pm * 256 + wr * 64 + fr, c8 = wc * 32 + 8 * fq, gl0 = grow_of_tile(u.pm, sl) + wr * 64 + fr;
        float rs[2][4];
#pragma unroll
        for (int ai = 0; ai < 2; ++ai)
#pragma unroll
            for (int m = 0; m < 4; ++m) rs[ai][m] = ((const LAS float*)(lds + RSTD_OFF + rsb * RSTD_BUF2))[wr * 64 + fr + ai * 128 + m * 16];
        bf16_t* dst = pb + off;
        if (type == 2) {
            unsigned char* g8 = (unsigned char*)dst + ((size_t)(u.pm * 12 + (pn - 21)) << 16) + (size_t)((((wr * 4 + wc) * 64) + fq * 16 + fr) * 16);
#pragma unroll
            for (int ai = 0; ai < 2; ++ai)
#pragma unroll
                for (int m = 0; m < 4; ++m) { u32x4 w; const float rn = rs[ai][m] * -1.4426950408889634f;
#pragma unroll
                    for (int bj = 0; bj < 2; ++bj) { f32x4 xa = acc[ai][bj][m][0] * rn, xb = acc[ai][bj][m][1] * rn;
                        SCHED_FENCE();
#pragma unroll
                        for (int j = 0; j < 4; ++j) { xa[j] = __builtin_amdgcn_exp2f(xa[j]); xb[j] = __builtin_amdgcn_exp2f(xb[j]); }
                        SCHED_FENCE();
                        xa = xa + 1.0f; xb = xb + 1.0f;
                        SCHED_FENCE();
#pragma unroll
                        for (int j = 0; j < 4; ++j) { xa[j] = __builtin_amdgcn_rcpf(xa[j]); xb[j] = __builtin_amdgcn_rcpf(xb[j]); }
                        SCHED_FENCE();
                        xa = xa * 256.0f + 0.5f; xb = xb * 256.0f + 0.5f;
                        const unsigned lo = q8c_(xa[0]) | (q8c_(xa[1]) << 8) | (q8c_(xa[2]) << 16) | (q8c_(xa[3]) << 24), hi = q8c_(xb[0]) | (q8c_(xb[1]) << 8) | (q8c_(xb[2]) << 16) | (q8c_(xb[3]) << 24);
                        if (bj == 0) { w.x = lo; w.y = hi; } else { w.z = lo; w.w = hi; } }
                    *(u32x4*)(g8 + (ai * 4 + m) * 8192) = w; asm volatile("" ::: "memory"); }
        } else if (type < 2) {
#pragma unroll
            for (int ai = 0; ai < 2; ++ai)
#pragma unroll
                for (int m = 0; m < 4; ++m) { const int r = rl0 + ai * 128 + m * 16;
#pragma unroll
                    for (int bj = 0; bj < 2; ++bj) { const float rsc = rs[ai][m] * scale, rn = rs[ai][m] * -1.4426950408889634f;
                        f32x4 va = acc[ai][bj][m][0] * rsc, vb = acc[ai][bj][m][1] * rsc;
                        if (type != 0) { f32x4 ea = acc[ai][bj][m][0] * rn, eb = acc[ai][bj][m][1] * rn;
                            SCHED_FENCE();
#pragma unroll
                            for (int j = 0; j < 4; ++j) { ea[j] = __builtin_amdgcn_exp2f(ea[j]); eb[j] = __builtin_amdgcn_exp2f(eb[j]); }
                            SCHED_FENCE();
                            ea = ea + 1.0f; eb = eb + 1.0f;
                            SCHED_FENCE();
#pragma unroll
                            for (int j = 0; j < 4; ++j) { ea[j] = __builtin_amdgcn_rcpf(ea[j]); eb[j] = __builtin_amdgcn_rcpf(eb[j]); }
                            SCHED_FENCE();
                            va = va * ea; vb = vb * eb; }
                        u32x4 w;
                        w.x = cvt_pk_bf16(va[0], va[1]); w.y = cvt_pk_bf16(va[2], va[3]); w.z = cvt_pk_bf16(vb[0], vb[1]); w.w = cvt_pk_bf16(vb[2], vb[3]);
                        *(u32x4*)(dst + (size_t)r * ldc + cb + c8 + bj * 128) = w; }
                    asm volatile("" ::: "memory"); }
        } else if (type == 3) {
            bf16_t* dq = pb + PO_AQ; bf16_t* dk = pb + PO_AK;
#pragma unroll
            for (int ai = 0; ai < 2; ++ai)
#pragma unroll
                for (int n = 0; n < 2; ++n) { const int cc = cb + c8 + 4 * n;
                    const f32x4 lbv = *(const LAS f32x4*)(lds + LBV_OFF + cc * 4);
                    float lg[4][4];
#pragma unroll
                    for (int m = 0; m < 4; ++m) { float tt[4]; const float rn = rs[ai][m] * -1.4426950408889634f;
#pragma unroll
                        for (int j = 0; j < 4; ++j) tt[j] = fminf(acc[ai][1][m][n][j] * rn, 115.0f);
                        SCHED_FENCE();
#pragma unroll
                        for (int j = 0; j < 4; ++j) tt[j] = __builtin_amdgcn_exp2f(tt[j]);
                        SCHED_FENCE();
#pragma unroll
                        for (int j = 0; j < 4; ++j) tt[j] = __builtin_amdgcn_rcpf(1.0f + tt[j]);
                        SCHED_FENCE();
#pragma unroll
                        for (int j = 0; j < 4; ++j) lg[m][j] = __builtin_amdgcn_logf(lbv[j] + (1.0f - lbv[j]) * tt[j]); }
                    float offs[4], rref[4];
#pragma unroll
                    for (int j = 0; j < 4; ++j) { offs[j] = 0.f; rref[j] = 0.f; }
#pragma unroll
                    for (int m = 0; m < 4; ++m) {
#pragma unroll
                        for (int j = 0; j < 4; ++j) { float v = lg[m][j];
                            v += __builtin_bit_cast(float, __builtin_amdgcn_update_dpp(0, __builtin_bit_cast(int, v), 0x111, 0xF, 0xF, true));
                            v += __builtin_bit_cast(float, __builtin_amdgcn_update_dpp(0, __builtin_bit_cast(int, v), 0x112, 0xF, 0xF, true));
                            v += __builtin_bit_cast(float, __builtin_amdgcn_update_dpp(0, __builtin_bit_cast(int, v), 0x114, 0xF, 0xF, true));
                            v += __builtin_bit_cast(float, __builtin_amdgcn_update_dpp(0, __builtin_bit_cast(int, v), 0x118, 0xF, 0xF, true));
                            const float tot = __builtin_bit_cast(float, __builtin_amdgcn_update_dpp(0, __builtin_bit_cast(int, v), 0x15F, 0xF, 0xF, false));
                            lg[m][j] = v + offs[j]; offs[j] += tot;
                            if (m == 1) rref[j] = offs[j]; } }
#pragma unroll
                    for (int m = 0; m < 4; ++m) { const int r = rl0 + ai * 128 + m * 16; float qv[4], sg[4], eq[4], ek[4], tt[4];
#pragma unroll
                        for (int j = 0; j < 4; ++j) { tt[j] = fminf(acc[ai][1][m][n][j] * (rs[ai][m] * -1.4426950408889634f), 115.0f); qv[j] = acc[ai][0][m][n][j] * rs[ai][m]; eq[j] = lg[m][j] - rref[j]; ek[j] = -eq[j]; }
                        SCHED_FENCE();
#pragma unroll
                        for (int j = 0; j < 4; ++j) { tt[j] = __builtin_amdgcn_exp2f(tt[j]); eq[j] = __builtin_amdgcn_exp2f(eq[j]); ek[j] = __builtin_amdgcn_exp2f(ek[j]); }
                        sigmoidN<4>(qv, sg);
#pragma unroll
                        for (int j = 0; j < 4; ++j) { qv[j] = qv[j] * sg[j] * 0.08838834764831845f * eq[j]; ek[j] *= (1.0f - lbv[j]) * tt[j] * __builtin_amdgcn_rcpf(1.0f + tt[j]); }
                        u32x2 wq, wk;
                        wq.x = cvt_pk_bf16(qv[0], qv[1]); wq.y = cvt_pk_bf16(qv[2], qv[3]); wk.x = cvt_pk_bf16(ek[0], ek[1]); wk.y = cvt_pk_bf16(ek[2], ek[3]);
                        const size_t o = (size_t)r * 512 + cc;
                        *(u32x2*)(dq + o) = wq; *(u32x2*)(dk + o) = wk; }
                    if (fr == 0) {
                        const int gch = (gl0 - fr + ai * 128) >> 6;
                        float* pe = dec + ((size_t)gch * 4 + pn) * 128 + c8 + 4 * n; float* pl = pe + (size_t)1024 * 4 * 128;
                        f32x4 e0, l0;
#pragma unroll
                        for (int j = 0; j < 4; ++j) { e0[j] = ex2_(rref[j]); l0[j] = ex2_(offs[j] - rref[j]); }
                        *(f32x4*)pe = e0; *(f32x4*)pl = l0; }
                    asm volatile("" ::: "memory"); }
        } else if (type == 4 || type == 5) {
#pragma unroll
            for (int bj = 0; bj < 2; ++bj) { const int c = c8 + bj * 128, hh = c >> 6, i0 = (c & 63) >> 1; const float l2g = lg2gamma(hh);
#pragma unroll
                for (int ai = 0; ai < 2; ++ai) { f32x4 csv[4][2];
#pragma unroll
                    for (int m = 0; m < 4; ++m) { const int pos = (gl0 + ai * 128 + m * 16) & (SEQ - 1); csv[m][0] = *(const f32x4*)(rope + ((size_t)pos * 32 + i0) * 2); csv[m][1] = *(const f32x4*)(rope + ((size_t)pos * 32 + i0) * 2 + 4); }
#pragma unroll
                    for (int m = 0; m < 4; ++m) { const int r = rl0 + ai * 128 + m * 16, pos = (gl0 + ai * 128 + m * 16) & (SEQ - 1), tc = pos & 63;
                        const f32x4 cs0 = csv[m][0], cs1 = csv[m][1];
                        const float fac = (type == 4) ? ex2_((float)(tc - REFROW) * l2g) : 0.125f * ex2_((float)(REFROW - tc) * l2g);
                        float v[8];
#pragma unroll
                        for (int j = 0; j < 8; ++j) v[j] = acc[ai][bj][m][j >> 2][j & 3] * rs[ai][m];
                        float o[8];
                        o[0] = v[0] * cs0[0] - v[1] * cs0[1]; o[1] = v[0] * cs0[1] + v[1] * cs0[0];
                        o[2] = v[2] * cs0[2] - v[3] * cs0[3]; o[3] = v[2] * cs0[3] + v[3] * cs0[2];
                        o[4] = v[4] * cs1[0] - v[5] * cs1[1]; o[5] = v[4] * cs1[1] + v[5] * cs1[0];
                        o[6] = v[6] * cs1[2] - v[7] * cs1[3]; o[7] = v[6] * cs1[3] + v[7] * cs1[2];
                        u32x4 w;
                        w.x = cvt_pk_bf16(o[0] * fac, o[1] * fac); w.y = cvt_pk_bf16(o[2] * fac, o[3] * fac); w.z = cvt_pk_bf16(o[4] * fac, o[5] * fac); w.w = cvt_pk_bf16(o[6] * fac, o[7] * fac);
                        *(u32x4*)(dst + (size_t)r * 256 + c) = w; asm volatile("" ::: "memory"); } } }
        } else {
#pragma unroll
            for (int bj = 0; bj < 2; ++bj) { const int c = c8 + bj * 128; float bg[8]; { const f32x4 l0 = *(const LAS f32x4*)(lds + BGK_OFF + c * 4), l1 = *(const LAS f32x4*)(lds + BGK_OFF + c * 4 + 16);
#pragma unroll
                    for (int j = 0; j < 4; ++j) { bg[j] = l0[j]; bg[4 + j] = l1[j]; } }
#pragma unroll
                for (int ai = 0; ai < 2; ++ai)
#pragma unroll
                    for (int m = 0; m < 4; ++m) { const int r = rl0 + ai * 128 + m * 16; float lg[8];
                        float xx[8], ee[8];
#pragma unroll
                        for (int j = 0; j < 8; ++j) { xx[j] = acc[ai][bj][m][j >> 2][j & 3] * rs[ai][m] + bg[j]; ee[j] = fabsf(xx[j]) * -1.4426950408889634f; }
                        SCHED_FENCE();
#pragma unroll
                        for (int j = 0; j < 8; ++j) ee[j] = __builtin_amdgcn_exp2f(ee[j]);
                        SCHED_FENCE();
#pragma unroll
                        for (int j = 0; j < 8; ++j) ee[j] = 1.0f + ee[j];
                        SCHED_FENCE();
#pragma unroll
                        for (int j = 0; j < 8; ++j) ee[j] = __builtin_amdgcn_logf(ee[j]);
                        SCHED_FENCE();
#pragma unroll
                        for (int j = 0; j < 8; ++j) lg[j] = -(fmaxf(-xx[j], 0.0f) + ee[j] * 0.6931471805599453f) * (1.0f / 16.0f);
                        u32x4 h; h.x = pk2h(lg[0], lg[1]); h.y = pk2h(lg[2], lg[3]); h.z = pk2h(lg[4], lg[5]); h.w = pk2h(lg[6], lg[7]);
                        *(u32x4*)(dst + (size_t)r * 256 + c) = h; asm volatile("" ::: "memory"); } }
        }
    }
};
struct EpiGate {
    static constexpr bool PERM = true, AFTER_DRAIN = false, MID = true, ALIGN = true, RSTD = false;
    const unsigned char* mg8; bf16_t* out;
    __device__ __forceinline__ void mid(f32x4 (&acc)[2][2][4][2], const pg8::Unit& u, int t, int wr, int wc, int fr, int fq) const {
        asm volatile("" : "+v"(fr), "+v"(fq));
        const unsigned char* tb = mg8 + ((size_t)(u.pm * 12 + u.pn + (t == 8 ? 0 : 4)) << 16) + (size_t)((((wr * 4 + wc) * 64) + fq * 16 + fr) * 16);
        u32x4 gnv[2][4], gdv[2][4];
#pragma unroll
        for (int ai = 0; ai < 2; ++ai)
#pragma unroll
            for (int m = 0; m < 4; ++m) { gnv[ai][m] = *(const u32x4*)(tb + (ai * 4 + m) * 8192); gdv[ai][m] = *(const u32x4*)(tb + 4 * 65536 + (ai * 4 + m) * 8192); }
#pragma unroll
        for (int ai = 0; ai < 2; ++ai)
#pragma unroll
            for (int m = 0; m < 4; ++m) { const u32x4 gn = gnv[ai][m], gd = gdv[ai][m];
#pragma unroll
                for (int bj = 0; bj < 2; ++bj) { const unsigned n0 = bj ? gn.z : gn.x, n1 = bj ? gn.w : gn.y, d0 = bj ? gd.z : gd.x, d1 = bj ? gd.w : gd.y;
                    f32x4& a0 = acc[ai][bj][m][0]; f32x4& a1 = acc[ai][bj][m][1];
                    a0[0] *= ub0(n0) * __builtin_amdgcn_rcpf(ub0(d0)); a0[1] *= ub1(n0) * __builtin_amdgcn_rcpf(ub1(d0));
                    a0[2] *= ub2(n0) * __builtin_amdgcn_rcpf(ub2(d0)); a0[3] *= ub3(n0) * __builtin_amdgcn_rcpf(ub3(d0));
                    a1[0] *= ub0(n1) * __builtin_amdgcn_rcpf(ub0(d1)); a1[1] *= ub1(n1) * __builtin_amdgcn_rcpf(ub1(d1));
                    a1[2] *= ub2(n1) * __builtin_amdgcn_rcpf(ub2(d1)); a1[3] *= ub3(n1) * __builtin_amdgcn_rcpf(ub3(d1)); } }
    }
    __device__ __forceinline__ void operator()(const f32x4 (&acc)[2][2][4][2], const pg8::Unit& u, int wr, int wc, int fr, int fq, int rsb) const {
        asm volatile("" : "+v"(fr), "+v"(fq));
        const int rl0 = u.pm * 256 + wr * 64 + fr, c0 = u.pn * 256 + wc * 32 + 8 * fq;
        const unsigned char* tb = mg8 + ((size_t)(u.pm * 12 + u.pn + 8) << 16) + (size_t)((((wr * 4 + wc) * 64) + fq * 16 + fr) * 16);
        const float sc = 1.0f / 256.0f;
        u32x4 gwv[2][4];
#pragma unroll
        for (int ai = 0; ai < 2; ++ai)
#pragma unroll
            for (int m = 0; m < 4; ++m) gwv[ai][m] = *(const u32x4*)(tb + (ai * 4 + m) * 8192);
#pragma unroll
        for (int ai = 0; ai < 2; ++ai)
#pragma unroll
            for (int m = 0; m < 4; ++m) { const size_t rr = (size_t)(rl0 + ai * 128 + m * 16); const u32x4 gw = gwv[ai][m];
#pragma unroll
                for (int bj = 0; bj < 2; ++bj) { const unsigned g0 = bj ? gw.z : gw.x, g1 = bj ? gw.w : gw.y; const f32x4 a0 = acc[ai][bj][m][0] * sc, a1 = acc[ai][bj][m][1] * sc; u32x4 w;
                    w.x = cvt_pk_bf16(a0[0] * ub0(g0), a0[1] * ub1(g0)); w.y = cvt_pk_bf16(a0[2] * ub2(g0), a0[3] * ub3(g0));
                    w.z = cvt_pk_bf16(a1[0] * ub0(g1), a1[1] * ub1(g1)); w.w = cvt_pk_bf16(a1[2] * ub2(g1), a1[3] * ub3(g1));
                    *(u32x4*)(out + rr * 1024 + c0 + bj * 128) = w; } }
    }
};
struct EpiResid {
    static constexpr bool PERM = true, AFTER_DRAIN = false, MID = false, ALIGN = true, RSTD = false;
    bf16_t* xb; float* ssq; int sl;
    __device__ __forceinline__ void operator()(const f32x4 (&acc)[2][2][4][2], const pg8::Unit& u, int wr, int wc, int fr, int fq, int rsb) const {
        asm volatile("" : "+v"(fr), "+v"(fq));
        const int rl0 = grow_of_tile(u.pm, sl) + wr * 64 + fr, c0 = u.pn * 256 + wc * 32 + 8 * fq;
        u32x4 xiv[2][4][2];
#pragma unroll
        for (int ai = 0; ai < 2; ++ai)
#pragma unroll
            for (int m = 0; m < 4; ++m)
#pragma unroll
                for (int bj = 0; bj < 2; ++bj) xiv[ai][m][bj] = *(const u32x4*)(xb + (size_t)(rl0 + ai * 128 + m * 16) * D + c0 + bj * 128);
#pragma unroll
        for (int ai = 0; ai < 2; ++ai)
#pragma unroll
            for (int m = 0; m < 4; ++m) { const int r = rl0 + ai * 128 + m * 16; const size_t ro = (size_t)r * D + c0; float ss = 0.f;
                u32x4 xi[2]; xi[0] = xiv[ai][m][0]; xi[1] = xiv[ai][m][1];
#pragma unroll
                for (int bj = 0; bj < 2; ++bj) { const f32x4 a0 = acc[ai][bj][m][0], a1 = acc[ai][bj][m][1]; float v[8];
                    v[0] = bf_lo(xi[bj].x) + a0[0]; v[1] = bf_hi(xi[bj].x) + a0[1]; v[2] = bf_lo(xi[bj].y) + a0[2]; v[3] = bf_hi(xi[bj].y) + a0[3];
                    v[4] = bf_lo(xi[bj].z) + a1[0]; v[5] = bf_hi(xi[bj].z) + a1[1]; v[6] = bf_lo(xi[bj].w) + a1[2]; v[7] = bf_hi(xi[bj].w) + a1[3];
                    u32x4 w; w.x = cvt_pk_bf16(v[0], v[1]); w.y = cvt_pk_bf16(v[2], v[3]); w.z = cvt_pk_bf16(v[4], v[5]); w.w = cvt_pk_bf16(v[6], v[7]);
                    *(u32x4*)(xb + ro + bj * 128) = w;
                    ss += ((v[0] * v[0] + v[1] * v[1]) + (v[2] * v[2] + v[3] * v[3])) + ((v[4] * v[4] + v[5] * v[5]) + (v[6] * v[6] + v[7] * v[7])); }
                ss = xsum32(xsum16(ss));
                if (fq == 0) ssq[((size_t)u.pn * M + r) * 4 + wc] = ss; }
    }
};
struct EpiSwiGLU {
    static constexpr bool PERM = true, AFTER_DRAIN = false, MID = false, ALIGN = true, RSTD = true;
    const float* ssq; bf16_t* act; int sl; LAS unsigned char* lds;
    __device__ __forceinline__ void prep(int pm, int buf) const { panel_rstd_fill(lds, ssq, grow_of_tile(pm, sl), buf); }
    __device__ __forceinline__ void operator()(const f32x4 (&acc)[2][2][4][2], const pg8::Unit& u, int wr, int wc, int fr, int fq, int rsb) const {
        asm volatile("" : "+v"(fr), "+v"(fq));
        const int rl0 = u.pm * 256 + wr * 64 + fr, c0 = u.pn * 128 + wc * 32 + 8 * fq;
#pragma unroll
        for (int ai = 0; ai < 2; ++ai)
#pragma unroll
            for (int m = 0; m < 4; ++m) { const int r = rl0 + ai * 128 + m * 16; const float rs = ((const LAS float*)(lds + RSTD_OFF + rsb * RSTD_BUF2))[wr * 64 + fr + ai * 128 + m * 16];
                const float rn = rs * -1.4426950408889634f;
                f32x4 ga = acc[ai][0][m][0] * rs, gb = acc[ai][0][m][1] * rs, ea = acc[ai][0][m][0] * rn, eb = acc[ai][0][m][1] * rn;
                SCHED_FENCE();
#pragma unroll
                for (int j = 0; j < 4; ++j) { ea[j] = __builtin_amdgcn_exp2f(ea[j]); eb[j] = __builtin_amdgcn_exp2f(eb[j]); }
                SCHED_FENCE();
                ea = ea + 1.0f; eb = eb + 1.0f;
                SCHED_FENCE();
#pragma unroll
                for (int j = 0; j < 4; ++j) { ea[j] = __builtin_amdgcn_rcpf(ea[j]); eb[j] = __builtin_amdgcn_rcpf(eb[j]); }
                SCHED_FENCE();
                const f32x4 aa = (ga * ea) * (acc[ai][1][m][0] * rs), ab = (gb * eb) * (acc[ai][1][m][1] * rs);
                u32x4 w; w.x = cvt_pk_bf16(aa[0], aa[1]); w.y = cvt_pk_bf16(aa[2], aa[3]); w.z = cvt_pk_bf16(ab[0], ab[1]); w.w = cvt_pk_bf16(ab[2], ab[3]);
                *(u32x4*)(act + (size_t)r * FF + c0) = w; }
    }
};

__device__ __forceinline__ void tr_item(const float* src, int lds_, int scol0, int k0, const float* scale, int smask, bf16_t* dst, int ldd, int drow0, int dcol0, LAS float* scr, int lane) {
    float wv_[32], sv_[32];
#pragma unroll
    for (int i = 0; i < 32; ++i) { const int kk = 2 * i + (lane >> 5); wv_[i] = src[(size_t)(k0 + kk) * lds_ + scol0 + (lane & 31)]; sv_[i] = scale ? scale[(k0 + kk) & smask] : 1.0f; }
#pragma unroll
    for (int i = 0; i < 32; ++i) { const int kk = 2 * i + (lane >> 5); scr[kk * 33 + (lane & 31)] = wv_[i] * sv_[i]; }
    LDS_WAIT(); asm volatile("" ::: "memory");
    const int c = lane & 7;
#pragma unroll
    for (int j = 0; j < 4; ++j) { const int n = (lane >> 3) + 8 * j; const LAS float* s = scr + (8 * c) * 33 + n;
        u32x4 o; o.x = pk2(s[0 * 33], s[1 * 33]); o.y = pk2(s[2 * 33], s[3 * 33]); o.z = pk2(s[4 * 33], s[5 * 33]); o.w = pk2(s[6 * 33], s[7 * 33]);
        *(u32x4*)(dst + (size_t)(drow0 + n) * ldd + dcol0 + k0 + 8 * c) = o; }
    LDS_WAIT(); asm volatile("" ::: "memory");
}
__device__ __forceinline__ void ph_prologue(const Params& P, LAS unsigned char* lds) {
    int tid = tid_(); asm volatile("" : "+v"(tid));
    const int lane = tid & 63, wave = __builtin_amdgcn_readfirstlane(tid >> 6);
    const int G = gridDim.x, gw = blockIdx.x * 8 + wave, NGW = G * 8;
    const size_t gt = (size_t)blockIdx.x * 512 + tid, NGT = (size_t)G * 512;
    unsigned char* ws = P.ws;
    const float* x = P.in[0]; const float* norm_mix = P.in[1]; const float* w_in = P.in[2]; const float* lb_logits = P.in[3]; const float* w_gk_up = P.in[4];
    const float* w_out = P.in[11]; const float* norm_ffn = P.in[12];
    const float* w_g = P.in[13]; const float* w_u = P.in[14]; const float* w_d = P.in[15];
    LAS float* scr = (LAS float*)(lds + wave * 16384);
    constexpr int I_IN = 16 * 256, I_BR = 3 * 8 * 32, I_OUT = 16 * 32, I_GU = 16 * (GU / 32), I_DN = (FF / 64) * 32, I_L = I_IN + I_BR + I_OUT + I_GU + I_DN;
    for (int it = gw; it < DEPTH * I_L; it += NGW) {
        const int l = it / I_L; int r = it % I_L;
        if (r < I_IN) { const int kb = r / 256, nb = r % 256; const int n0 = (nb < 160) ? nb * 32 : 5376 + (nb - 160) * 32; const int sc0 = (n0 < 1024) ? (((n0 & 255) < 128) ? (n0 >> 8) * 128 + (n0 & 255) : 512 + (n0 >> 8) * 128 + (n0 & 255) - 128) : (nb < 160) ? n0 : n0 - 240;
            tr_item(w_in + (size_t)l * D * PW, PW, sc0, kb * 64, norm_mix + l * D, 0xFFFF, (bf16_t*)(ws + WS_WIN + l * WIN_L), D, n0, 0, scr, lane); continue; }
        r -= I_IN;
        if (r < I_BR) { const int br = r / 256, kb = (r % 256) / 32, nb = r % 32;
            tr_item((br == 0 ? P.in[8] : br == 1 ? P.in[9] : P.in[10]) + (size_t)l * 512 * D, D, nb * 32, kb * 64, (br == 0 ? P.in[6] + l * 128 : br == 2 ? P.in[7] + l * 128 : nullptr), 127, (bf16_t*)(ws + WS_WBR + l * WBR_L), 1536, nb * 32, br * 512, scr, lane); continue; }
        r -= I_BR;
        if (r < I_OUT) { const int kb = r / 32, nb = r % 32;
            tr_item(w_out + (size_t)l * D * D, D, nb * 32, kb * 64, nullptr, 0, (bf16_t*)(ws + WS_WOUT + l * WOUT_L), D, nb * 32, 0, scr, lane); continue; }
        r -= I_OUT;
        if (r < I_GU) { const int kb = r / (GU / 32), nb = r % (GU / 32);
            { const int n0 = nb * 32, t = n0 >> 8, w0 = n0 & 255; const bool up = w0 >= 128;
                tr_item((up ? w_u : w_g) + (size_t)l * D * FF, FF, t * 128 + (w0 & 127), kb * 64, norm_ffn + l * D, 0xFFFF, (bf16_t*)(ws + WS_WGU + l * WGU_L), D, n0, 0, scr, lane); } continue; }
        r -= I_GU;
        { const int kb = r / 32, nb = r % 32;
            tr_item(w_d + (size_t)l * FF * D, D, nb * 32, kb * 64, nullptr, 0, (bf16_t*)(ws + WS_WDN + l * WDN_L), FF, nb * 32, 0, scr, lane); }
    }
    for (size_t it = gt; it < (size_t)DEPTH * 256 * 128; it += NGT) {
        const int l = (int)(it / (256 * 128)), rr = (int)(it % (256 * 128)), j = rr % 256, kc = rr / 256;
        float up[16];
#pragma unroll
        for (int r = 0; r < 16; ++r) up[r] = w_gk_up[((size_t)l * 16 + r) * 256 + j];
        float o[8];
#pragma unroll
        for (int kk = 0; kk < 8; ++kk) { const int k = kc * 8 + kk; const float* wr_ = w_in + ((size_t)l * D + k) * PW + 5120; float s = 0.f;
#pragma unroll
            for (int r = 0; r < 16; ++r) s += wr_[r] * up[r];
            o[kk] = s * norm_mix[l * D + k]; }
        u32x4 w; w.x = pk2(o[0], o[1]); w.y = pk2(o[2], o[3]); w.z = pk2(o[4], o[5]); w.w = pk2(o[6], o[7]);
        *(u32x4*)((bf16_t*)(ws + WS_WIN + l * WIN_L) + (size_t)(5120 + j) * D + kc * 8) = w;
    }
    for (size_t it = gt; it < (size_t)SEQ * 32; it += NGT) {
        const int pos = (int)(it >> 5), i = (int)(it & 31);
        double a = -(double)i * (9.210340371976184 / 31.0) * (1.0 / 16.0), e = 1.0, term = 1.0;
#pragma unroll 1
        for (int n = 1; n <= 18; ++n) { term *= a / (double)n; e += term; }
        e *= e; e *= e; e *= e; e *= e;
        const double th = (double)pos * e;
        const double kq = __builtin_rint(th * 0.15915494309189535);
        double rr = __builtin_fma(-kq, 6.283185307179586, th); rr = __builtin_fma(-kq, 2.4492935982947064e-16, rr);
        const double r2 = rr * rr; double sn = 1.0, cs = 1.0;
#pragma unroll 1
        for (int n = 13; n >= 1; --n) { sn = 1.0 - sn * r2 / (double)((2 * n) * (2 * n + 1)); cs = 1.0 - cs * r2 / (double)((2 * n - 1) * (2 * n)); }
        sn *= rr;
        float* o = (float*)(ws + WS_ROPE) + it * 2; o[0] = (float)cs; o[1] = (float)sn;
    }
    if (blockIdx.x == 0) {
        float v[DEPTH], mx = -1e30f;
#pragma unroll
        for (int l = 0; l < DEPTH; ++l) { v[l] = lb_logits[l * 512 + tid]; mx = fmaxf(mx, v[l]); }
        float s = 0.f;
#pragma unroll
        for (int l = 0; l < DEPTH; ++l) { v[l] = expf(v[l] - mx); s += v[l]; }
        float c = 0.f; float* lbo = (float*)(ws + WS_LB);
#pragma unroll
        for (int l = 0; l < DEPTH; ++l) { if (l > 0) c += v[l] / s; lbo[l * 512 + tid] = c; }
    }
    bf16_t* xb = (bf16_t*)(ws + WS_XB); float* ssq = (float*)(ws + WS_SSQM);
    for (int m = gw; m < M; m += 2 * NGW) {
        const bool has1 = (m + NGW) < M; const int m1 = has1 ? m + NGW : m;
        const f32x4* xr0 = (const f32x4*)(x + (size_t)m * D) + lane; const f32x4* xr1 = (const f32x4*)(x + (size_t)m1 * D) + lane; f32x4 v0[4], v1[4]; float s0 = 0.f, s1 = 0.f;
#pragma unroll
        for (int j = 0; j < 4; ++j) { v0[j] = xr0[64 * j]; v1[j] = xr1[64 * j]; }
#pragma unroll
        for (int j = 0; j < 4; ++j) { s0 += (v0[j][0] * v0[j][0] + v0[j][1] * v0[j][1]) + (v0[j][2] * v0[j][2] + v0[j][3] * v0[j][3]); s1 += (v1[j][0] * v1[j][0] + v1[j][1] * v1[j][1]) + (v1[j][2] * v1[j][2] + v1[j][3] * v1[j][3]); }
        s0 = wave_sum(s0); s1 = wave_sum(s1);
        u32x2* o0 = (u32x2*)(xb + (size_t)m * D) + lane; u32x2* o1 = (u32x2*)(xb + (size_t)m1 * D) + lane;
#pragma unroll
        for (int j = 0; j < 4; ++j) { u32x2 w; w.x = pk2(v0[j][0], v0[j][1]); w.y = pk2(v0[j][2], v0[j][3]); o0[64 * j] = w; }
        if (lane < 16) ssq[((size_t)(lane >> 2) * M + m) * 4 + (lane & 3)] = (lane == 0) ? s0 : 0.f;
        if (has1) {
#pragma unroll
            for (int j = 0; j < 4; ++j) { u32x2 w; w.x = pk2(v1[j][0], v1[j][1]); w.y = pk2(v1[j][2], v1[j][3]); o1[64 * j] = w; }
            if (lane < 16) ssq[((size_t)(lane >> 2) * M + m1) * 4 + (lane & 3)] = (lane == 0) ? s1 : 0.f; }
    }
}

__device__ __forceinline__ void ph_final(const Params& P) {
    int tid = tid_(); asm volatile("" : "+v"(tid));
    const int lane = tid & 63, wave = tid >> 6; const int gw = blockIdx.x * 8 + wave, NGW = gridDim.x * 8;
    const float* ssq = (const float*)(P.ws + WS_SSQM); const float* nf = P.in[16]; const bf16_t* xb = (const bf16_t*)(P.ws + WS_XB);
    f32x4 wv[4];
#pragma unroll
    for (int j = 0; j < 4; ++j) wv[j] = ((const f32x4*)nf)[lane + 64 * j];
    for (int m = gw; m < M; m += 2 * NGW) {
        const bool has1 = (m + NGW) < M; const int m1 = has1 ? m + NGW : m;
        const u32x2* xr0 = (const u32x2*)(xb + (size_t)m * D) + lane; const u32x2* xr1 = (const u32x2*)(xb + (size_t)m1 * D) + lane;
        u32x2 w0[4], w1[4];
#pragma unroll
        for (int j = 0; j < 4; ++j) { w0[j] = xr0[64 * j]; w1[j] = xr1[64 * j]; }
        const float rs0 = __builtin_amdgcn_rsqf(ssq_row(ssq + (size_t)m * 4) * (1.0f / 1024.0f) + NORM_EPS), rs1 = __builtin_amdgcn_rsqf(ssq_row(ssq + (size_t)m1 * 4) * (1.0f / 1024.0f) + NORM_EPS);
        f32x4* o0 = (f32x4*)(P.out + (size_t)m * D) + lane; f32x4* o1 = (f32x4*)(P.out + (size_t)m1 * D) + lane;
#pragma unroll
        for (int j = 0; j < 4; ++j) { f32x4 v = {bf_lo(w0[j].x), bf_hi(w0[j].x), bf_lo(w0[j].y), bf_hi(w0[j].y)}; v = v * rs0 * wv[j]; o0[64 * j] = v; }
#pragma unroll
        for (int j = 0; j < 4; ++j) { f32x4 v = {bf_lo(w1[j].x), bf_hi(w1[j].x), bf_lo(w1[j].y), bf_hi(w1[j].y)}; v = v * rs1 * wv[j]; if (has1) o1[64 * j] = v; } }
}

struct ScanArgs {
    const bf16_t* q; const bf16_t* k; const bf16_t* lg; const bf16_t* v; const bf16_t* og;
    int ldqk, qkcol, vcol; size_t row0; const float* gn; bf16_t* o; int ocol; int hidx; int sl; float* state; float* elp; const float* dec; int gch0;
};

template <int NC> __device__ __forceinline__ unsigned img_off(unsigned row, unsigned ch) { return (512u * NC) * (row >> 3) + 512u * (ch >> 2) + 64u * (row & 7) + 16u * ((ch & 3) ^ ((row >> 2) & 3)); }
template <int NC> struct FragBase { unsigned rowb[2], trb[2];
    __device__ __forceinline__ void init(int lane) { const unsigned h = lane >> 5, l31 = lane & 31, blk = (lane >> 4) & 1, q = (lane & 15) >> 2, p = lane & 3;
        rowb[0] = img_off<NC>(l31, h); rowb[1] = img_off<NC>(l31, 2 + h);
        trb[0] = img_off<NC>(8 * h + q, 2 * blk + (p >> 1)) + 8 * (p & 1); trb[1] = img_off<NC>(8 * h + 4 + q, 2 * blk + (p >> 1)) + 8 * (p & 1) - 256; } };
template <int NC> __device__ __forceinline__ bf16x8 row_frag(const LAS unsigned char* img, const FragBase<NC>& fb, int rbase, int s) { return *(const LAS bf16x8*)(img + fb.rowb[s & 1] + 512 * (s >> 1) + 512 * NC * (rbase >> 3)); }
template <int NC> __device__ __forceinline__ bf16x8 tr_frag(const LAS unsigned char* img, const FragBase<NC>& fb, int c, int ks) {
    const s16x4 lo = __builtin_bit_cast(s16x4, __builtin_amdgcn_ds_read_tr16_b64_v4i16((LAS s16x4*)(img + fb.trb[0] + 1024 * NC * ks + 512 * c)));
    const s16x4 hi = __builtin_bit_cast(s16x4, __builtin_amdgcn_ds_read_tr16_b64_v4i16((LAS s16x4*)(img + fb.trb[1] + 1024 * NC * ks + 512 * c + 256)));
    return (bf16x8){lo[0], lo[1], lo[2], lo[3], hi[0], hi[1], hi[2], hi[3]};
}
#define MFMA32(a, b, c) __builtin_amdgcn_mfma_f32_32x32x16_bf16((a), (b), (c), 0, 0, 0)

template <int DK, int MODE  , int ABL = 0>
__device__ __forceinline__ void scan_unit(LAS unsigned char* lds, const ScanArgs a) {
    constexpr int NC = DK / 32, NT = DK / 64;
    constexpr bool GATED = (MODE == 2);
    constexpr int NQ = DK / 64;
    constexpr int NCP = DK / 2, RG = 512 / NCP, RPG = 64 / RG;
    constexpr int NCH = SSL / 64;
    LAS unsigned char* ST = lds + 106496; LAS unsigned char* OT = lds + 139264; LAS unsigned char* PPs = lds + 98304;
    LAS float* RED = (LAS float*)(lds + 156160); LAS float* FV = (LAS float*)(lds + 158208); LAS float* ELP = (LAS float*)(lds + 158720); LAS float* TOT = (LAS float*)(lds + 159232);
    int tid = tid_(); asm volatile("" : "+v"(tid));
    const int lane = tid & 63, wave = __builtin_amdgcn_readfirstlane(tid >> 6), hh = lane >> 5, l31 = lane & 31;
    const int ib = wave >> 2, nb = wave & 3;
    FragBase<NC> fbk; fbk.init(lane); FragBase<4> fb4; fb4.init(lane); FragBase<2> fb2; fb2.init(lane);
    const int cp = tid % NCP, rg = tid / NCP;
    const int vrow = tid >> 3, vch = (tid & 7) * 2;
    const int pcl = tid & 3, prow = 2 * ((tid >> 3) & 31) + ((tid >> 2) & 1), phi = tid >> 8;
    f32x16 Sacc[NT];
#pragma unroll
    for (int t = 0; t < NT; ++t)
#pragma unroll
        for (int r = 0; r < 16; ++r) Sacc[t][r] = 0.f;
    if (a.sl > 0) {
#pragma unroll
        for (int t = 0; t < NT; ++t)
#pragma unroll
            for (int r = 0; r < 16; ++r) Sacc[t][r] = a.state[(t * 16 + r) * 512 + tid]; }
    if (tid < DK) { if (GATED) ELP[tid] = (a.sl > 0) ? a.elp[tid] : 1.0f; else if (MODE == 1) { int hx_ = a.hidx; asm volatile("" : "+s"(hx_)); FV[tid] = exp2f(64.0f * lg2gamma(hx_)); } }
    __syncthreads();
    unsigned rq[GATED ? RPG : 1], rk[GATED ? RPG : 1], rl[GATED ? RPG : 1]; u32x4 rq4[NQ], rk4[NQ]; float fve = 1.0f, fvl = 1.0f;     u32x4 rv[2]; u32x4 rog[2]; float cb0[GATED ? RPG : 1], cb1[GATED ? RPG : 1]; float pre0 = 0.f, pre1 = 0.f;
#define SC_LOAD_RAW(c_) do { const size_t r0_ = a.row0 + (size_t)(c_) * 64; \
        if (GATED) { _Pragma("unroll") for (int rr = 0; rr < RPG; ++rr) { const size_t ro_ = (r0_ + rg * RPG + rr) * a.ldqk + a.qkcol + 2 * cp; \
                rq[rr] = *(const unsigned*)(a.q + ro_); rk[rr] = *(const unsigned*)(a.k + ro_); } } \
        else { _Pragma("unroll") for (int i = 0; i < NQ; ++i) { const size_t ro_ = (r0_ + prow) * a.ldqk + a.qkcol + (pcl + 4 * (phi * NQ + i)) * 8; rq4[i] = *(const u32x4*)(a.q + ro_); rk4[i] = *(const u32x4*)(a.k + ro_); } \
            if (MODE == 3) { if (tid < DK) { const int gc_ = a.gch0 + (c_); const float e_ = a.dec[((size_t)gc_ * 4 + a.hidx) * 128 + tid]; \
                    const float l_ = ((gc_ & 63) > 0) ? a.dec[(size_t)1024 * 4 * 128 + ((size_t)(gc_ - 1) * 4 + a.hidx) * 128 + tid] : 1.0f; fve = e_; fvl = l_; } } } \
        _Pragma("unroll") for (int i = 0; i < 2; ++i) rv[i] = *(const u32x4*)(a.v + (r0_ + prow) * 512 + a.vcol + (pcl + 4 * (phi * 2 + i)) * 8); } while (0)
#define SC_LOAD_G(c_) do { if (GATED) { const size_t r0_ = a.row0 + (size_t)(c_) * 64; \
        _Pragma("unroll") for (int rr = 0; rr < RPG; ++rr) rl[rr] = *(const unsigned*)(a.lg + (r0_ + rg * RPG + rr) * a.ldqk + a.qkcol + 2 * cp); } } while (0)
#define SC_PREP1() do { if (GATED) { float s0 = 0.f, s1 = 0.f; \
        _Pragma("unroll") for (int rr = 0; rr < RPG; ++rr) { s0 += h_lo(rl[rr]); s1 += h_hi(rl[rr]); cb0[rr] = s0; cb1[rr] = s1; } \
        float e0_, d0_, e1_, d1_; halves32(s0, e0_, d0_); halves32(s1, e1_, d1_);          \
        pre0 = hh ? e0_ : 0.f; pre1 = hh ? e1_ : 0.f; \
        if (hh == 0) *(LAS f32x2*)(TOT + wave * DK + 2 * cp) = (f32x2){e0_ + d0_, e1_ + d1_}; } } while (0)
#define SC_PREP(b_) do { LAS unsigned char* QT_ = lds + (b_) * 49152; LAS unsigned char* KH_ = QT_ + 16384; LAS unsigned char* VV_ = QT_ + 32768; \
        if (GATED) { float o0 = 0.f, o1 = 0.f, r0 = 0.f, r1 = 0.f, t0 = 0.f, t1 = 0.f; \
            _Pragma("unroll") for (int g = 0; g < RG / 2; ++g) { const f32x2 t = *(const LAS f32x2*)(TOT + g * DK + 2 * cp); if (g < wave) { o0 += t.x; o1 += t.y; } if (g < RG / 4) { r0 += t.x; r1 += t.y; } t0 += t.x; t1 += t.y; }     \
            o0 += pre0; o1 += pre1; \
            _Pragma("unroll") for (int hb_ = 0; hb_ < RPG; hb_ += 4) { float x0_[4], x1_[4], eq0_[4], eq1_[4], ek0_[4], ek1_[4]; \
            _Pragma("unroll") for (int rr = 0; rr < 4; ++rr) { x0_[rr] = (cb0[hb_ + rr] + o0 - r0) * 1.4426950408889634f; x1_[rr] = (cb1[hb_ + rr] + o1 - r1) * 1.4426950408889634f; } \
            SCHED_FENCE(); \
            _Pragma("unroll") for (int rr = 0; rr < 4; ++rr) { eq0_[rr] = __builtin_amdgcn_exp2f(x0_[rr]); eq1_[rr] = __builtin_amdgcn_exp2f(x1_[rr]); ek0_[rr] = __builtin_amdgcn_exp2f(-x0_[rr]); ek1_[rr] = __builtin_amdgcn_exp2f(-x1_[rr]); } \
            SCHED_FENCE(); \
            _Pragma("unroll") for (int rr = 0; rr < 4; ++rr) { const int row = rg * RPG + hb_ + rr; const unsigned ad = img_off<NC>(row, cp >> 2) + (cp & 3) * 4; \
                *(LAS unsigned*)(QT_ + ad) = cvt_pk_bf16(eq0_[rr] * bf_lo(rq[hb_ + rr]), eq1_[rr] * bf_hi(rq[hb_ + rr])); *(LAS unsigned*)(KH_ + ad) = cvt_pk_bf16(ek0_[rr] * bf_lo(rk[hb_ + rr]), ek1_[rr] * bf_hi(rk[hb_ + rr])); } \
            SCHED_FENCE(); } \
            if (rg == 0) { const f32x2 ep = *(const LAS f32x2*)(ELP + 2 * cp); *(LAS f32x2*)(FV + 2 * cp) = (f32x2){ep.x * exp_(r0), ep.y * exp_(r1)}; *(LAS f32x2*)(ELP + 2 * cp) = (f32x2){exp_(t0 - r0), exp_(t1 - r1)}; } \
        } else { _Pragma("unroll") for (int i = 0; i < NQ; ++i) { const unsigned ad = img_off<NC>(prow, pcl + 4 * (phi * NQ + i)); *(LAS u32x4*)(QT_ + ad) = rq4[i]; *(LAS u32x4*)(KH_ + ad) = rk4[i]; } if (MODE == 3) { if (tid < DK) FV[tid] = fve * fvl; } } \
        _Pragma("unroll") for (int i = 0; i < 2; ++i) *(LAS u32x4*)(VV_ + img_off<4>(prow, pcl + 4 * (phi * 2 + i))) = rv[i]; } while (0)
#define SC_STATE_IMG() do { _Pragma("unroll") for (int t = 0; t < NT; ++t) { const int kb = NT * (wave >> 2) + t; \
            _Pragma("unroll") for (int q4 = 0; q4 < 4; ++q4) { const f32x4 fv = *(const LAS f32x4*)(FV + 32 * kb + 8 * q4 + 4 * hh); \
                _Pragma("unroll") for (int e = 0; e < 4; ++e) Sacc[t][4 * q4 + e] *= fv[e]; \
                u32x2 w; w.x = cvt_pk_bf16(Sacc[t][4 * q4], Sacc[t][4 * q4 + 1]); w.y = cvt_pk_bf16(Sacc[t][4 * q4 + 2], Sacc[t][4 * q4 + 3]); \
                *(LAS u32x2*)(ST + img_off<NC>(32 * nb + l31, 4 * kb + q4) + 8 * hh) = w; } } } while (0)
#define SC_PTILES(b_) do { if (wave < 3) { const LAS unsigned char* QT_ = lds + (b_) * 49152; const LAS unsigned char* KH_ = QT_ + 16384; LAS unsigned char* PP_ = PPs; \
            const int jb = (wave == 2) ? 1 : 0, pib = (wave == 0) ? 0 : 1; f32x16 pt; \
            _Pragma("unroll") for (int r = 0; r < 16; ++r) pt[r] = 0.f; \
            _Pragma("unroll") for (int s = 0; s < DK / 16; ++s) pt = MFMA32(row_frag<NC>(KH_, fbk, 32 * jb, s), row_frag<NC>(QT_, fbk, 32 * pib, s), pt); \
            const int ig = 32 * pib + l31; \
            _Pragma("unroll") for (int q4 = 0; q4 < 4; ++q4) { const int j0 = 32 * jb + 8 * q4 + 4 * hh; float pv[4]; \
                _Pragma("unroll") for (int e = 0; e < 4; ++e) pv[e] = (j0 + e <= ig) ? pt[4 * q4 + e] : 0.f; \
                u32x2 w; w.x = cvt_pk_bf16(pv[0], pv[1]); w.y = cvt_pk_bf16(pv[2], pv[3]); \
                *(LAS u32x2*)(PP_ + img_off<2>(ig, 4 * jb + q4) + 8 * hh) = w; } } } while (0)

#define SC_OUT_PASS(c_) do { const size_t ro_ = (a.row0 + (size_t)(c_) * 64 + vrow) * 1536 + a.ocol + vch * 8; \
        _Pragma("unroll") for (int i = 0; i < 2; ++i) { const u32x2 y0_ = *(const LAS u32x2*)(OT + vrow * 264 + (vch + i) * 16), y1_ = *(const LAS u32x2*)(OT + vrow * 264 + (vch + i) * 16 + 8); const u32x4 yv = {y0_.x, y0_.y, y1_.x, y1_.y}; const u32x4 gv = rog[i]; u32x4 w; \
            w.x = cvt_pk_bf16(bf_lo(yv.x) * bf_lo(gv.x), bf_hi(yv.x) * bf_hi(gv.x)); w.y = cvt_pk_bf16(bf_lo(yv.y) * bf_lo(gv.y), bf_hi(yv.y) * bf_hi(gv.y)); \
            w.z = cvt_pk_bf16(bf_lo(yv.z) * bf_lo(gv.z), bf_hi(yv.z) * bf_hi(gv.z)); w.w = cvt_pk_bf16(bf_lo(yv.w) * bf_lo(gv.w), bf_hi(yv.w) * bf_hi(gv.w)); \
            if (!(ABL & 16)) *(u32x4*)(a.o + ro_ + i * 8) = w; else asm volatile("" :: "v"(w)); } } while (0)
#define SC_LOAD_OG(c_) do { const size_t ro_ = (a.row0 + (size_t)(c_) * 64 + vrow) * 512 + a.vcol + vch * 8; \
        _Pragma("unroll") for (int i = 0; i < 2; ++i) rog[i] = *(const u32x4*)(a.og + ro_ + i * 8); } while (0)
    SC_LOAD_G(0); SC_LOAD_RAW(0);
    SC_PREP1();
    __syncthreads();
    SC_PREP(0);
    SC_LOAD_G(1); SC_LOAD_RAW(1);
    __syncthreads();
    SC_STATE_IMG();
    SC_PTILES(0);
    SC_PREP1();
    SC_LOAD_G(2);
    __syncthreads();
    for (int c = 0; c < NCH; ++c) {
        const int bc = c & 1, bn = bc ^ 1;
        const LAS unsigned char* QT = lds + bc * 49152; const LAS unsigned char* KH = QT + 16384; const LAS unsigned char* VV = QT + 32768; const LAS unsigned char* PP = PPs;
        if (c > 0) SC_OUT_PASS(c - 1);
        SC_LOAD_OG(c);
        f32x16 ot;
#pragma unroll
        for (int r = 0; r < 16; ++r) ot[r] = 0.f;
        if (!(ABL & 2)) {
#pragma unroll
        for (int s = 0; s < DK / 16; ++s) ot = MFMA32(row_frag<NC>(ST, fbk, 32 * nb, s), row_frag<NC>(QT, fbk, 32 * ib, s), ot); }
        bf16x8 vf[4];
#pragma unroll
        for (int s = 0; s < 4; ++s) vf[s] = tr_frag<4>(VV, fb4, nb, s);
        if (!(ABL & 2)) {
#pragma unroll
        for (int s = 0; s < 4; ++s) if (s < 2 || ib == 1) ot = MFMA32(vf[s], row_frag<2>(PP, fb2, 32 * ib, s), ot); }
        if (!(ABL & 4)) {
#pragma unroll
        for (int t = 0; t < NT; ++t) { const int kb = NT * (wave >> 2) + t;
#pragma unroll
            for (int s = 0; s < 4; ++s) Sacc[t] = MFMA32(tr_frag<NC>(KH, fbk, kb, s), vf[s], Sacc[t]); } }
        else { asm volatile("" :: "v"(vf[0]), "v"(vf[1]), "v"(vf[2]), "v"(vf[3])); }
        if (!(ABL & 1)) { SC_PREP(bn); } else { if (GATED) { asm volatile("" :: "v"(rq[0]), "v"(rk[0]), "v"(rq[RPG - 1]), "v"(rk[RPG - 1])); } else { asm volatile("" :: "v"(rq4[0]), "v"(rk4[0])); } asm volatile("" :: "v"(rv[0]), "v"(rv[1])); }
        { float ss = 0.f, sm = 0.f;
#pragma unroll
            for (int r = 0; r < 16; ++r) { ss += ot[r] * ot[r]; sm += ot[r]; }
            ss = xsum32(ss); sm = xsum32(sm);
            if (hh == 0) *(LAS f32x2*)(RED + ((32 * ib + l31) * 4 + nb) * 2) = (f32x2){ss, sm}; }
        __syncthreads();
        SC_LOAD_RAW(c + 2 < NCH ? c + 2 : NCH - 1);
        { const LAS f32x4* rp = (const LAS f32x4*)(RED + (32 * ib + l31) * 8); const f32x4 r0 = rp[0], r1 = rp[1];
            const float ss = (r0[0] + r0[2]) + (r1[0] + r1[2]), sm = (r0[1] + r0[3]) + (r1[1] + r1[3]);
            float mu = 0.f, rs;
            if (MODE == 1) { mu = sm * (1.0f / 128.0f); rs = __builtin_amdgcn_rsqf(ss * (1.0f / 128.0f) - mu * mu + NORM_EPS); }
            else rs = __builtin_amdgcn_rsqf(ss * (1.0f / 128.0f) + NORM_EPS);
#pragma unroll
            for (int q4 = 0; q4 < 4; ++q4) { float y[4];
#pragma unroll
                for (int e = 0; e < 4; ++e) y[e] = (ot[4 * q4 + e] - mu) * rs;
                u32x2 w; w.x = cvt_pk_bf16(y[0], y[1]); w.y = cvt_pk_bf16(y[2], y[3]);
                *(LAS u32x2*)(OT + (32 * ib + l31) * 264 + (32 * nb + 8 * q4 + 4 * hh) * 2) = w; } }
        if (c + 1 < NCH) { SC_STATE_IMG(); if (!(ABL & 8)) { SC_PTILES(bn); } }
        if (!(ABL & 1)) { SC_PREP1(); } else if (GATED) { asm volatile("" :: "v"(rl[0]), "v"(rl[RPG - 1])); }
        SC_LOAD_G(c + 3 < NCH ? c + 3 : NCH - 1);
        __syncthreads();
    }
    SC_OUT_PASS(NCH - 1);
#undef SC_OUT_PASS
#undef SC_LOAD_OG
#undef SC_LOAD_RAW
#undef SC_LOAD_G
#undef SC_PREP1
#undef SC_PREP
#undef SC_STATE_IMG
#undef SC_PTILES
    if (a.sl + 1 < NSL) {
#pragma unroll
        for (int t = 0; t < NT; ++t)
#pragma unroll
            for (int r = 0; r < 16; ++r) a.state[(t * 16 + r) * 512 + tid] = Sacc[t][r];
        if (GATED && tid < DK) a.elp[tid] = ELP[tid]; }
}

__device__ __forceinline__ void inproj_setup(const Params& P, int l, LAS unsigned char* lds) {
    int t_ = tid_(); asm volatile("" : "+v"(t_));
    if (t_ == 0) *(LAS int*)(lds + RSTD_OFF + 1024) = -1;
    if (t_ < 128) ((LAS f32x4*)(lds + LBV_OFF))[t_] = ((const f32x4*)((const float*)(P.ws + WS_LB) + l * 512))[t_];
    else if (t_ < 192) ((LAS f32x4*)(lds + BGK_OFF))[t_ - 128] = ((const f32x4*)(P.in[5] + l * 256))[t_ - 128];
    __syncthreads();
}
constexpr int NDEF = 3;
__device__ __forceinline__ void ph_scan(const Params& P, int l, int sl, LAS unsigned char* lds) {
    const int u = blockIdx.x, NSC = 3 * NBATCH * 4;
    if (u < NSC) {
        const int mix = u / (NBATCH * 4), bl = (u % (NBATCH * 4)) / 4, h = u % 4;
        const bf16_t* pb = (const bf16_t*)(P.ws + WS_PROJ);
        ScanArgs a; a.sl = sl; a.state = (float*)(P.ws + WS_STATE) + (size_t)u * 16384; a.elp = (float*)(P.ws + WS_ELP) + u * 128; a.row0 = (size_t)bl * SSL; a.o = (bf16_t*)(P.ws + WS_O); a.ocol = mix * 512 + h * 128; a.vcol = h * 128; a.hidx = h; a.gn = nullptr; a.lg = nullptr; a.dec = (const float*)(P.ws + WS_DEC); a.gch0 = bl * 64 + sl * (SSL / 64);
        if (mix == 0) { a.q = pb + PO_AQ; a.k = pb + PO_AK; a.v = pb + PO_AV; a.og = pb + PO_AOG; a.ldqk = 512; a.qkcol = h * 128; scan_unit<128, 3>(lds, a); }
        else if (mix == 1) { a.q = pb + PO_BQ; a.k = pb + PO_BK; a.v = pb + PO_BV; a.og = pb + PO_BOG; a.ldqk = 256; a.qkcol = h * 64; scan_unit<64, 1>(lds, a); }
        else { a.q = pb + PO_CQ; a.k = pb + PO_CK; a.lg = pb + PO_CLG; a.v = pb + PO_CV; a.og = pb + PO_COG; a.ldqk = 256; a.qkcol = h * 64; a.gn = P.in[7] + l * 128; scan_unit<64, 2>(lds, a); }
        if (u < NBATCH * 4) return;
        __syncthreads();
    }
    pg8::ListOrder S;
    if (u >= NSC) S = pg8::ListOrder{u - NSC, (int)gridDim.x - NSC, 2, 4, PN / 256 - NDEF};
    else          S = pg8::ListOrder{u - NBATCH * 4, 0, 1, 1, PN / 256 - 1};
    pg8::Gemm g{(const bf16_t*)(P.ws + WS_XB), (const bf16_t*)(P.ws + WS_WIN + l * WIN_L), MS, PN, D, D, 1, sl};
    EpiInProj E{(const float*)(P.ws + WS_SSQM), (const float*)(P.ws + WS_LB) + l * 512, P.in[5] + l * 256, (const float*)(P.ws + WS_ROPE), (bf16_t*)(P.ws + WS_PROJ), sl, lds, (float*)(P.ws + WS_DEC)};
    pg8::gemm_phase<EpiInProj, pg8::ListOrder>(lds, g, S, E);
}

__device__ __forceinline__ void zero_f32(float* p, int n) { int t_ = tid_(); asm volatile("" : "+v"(t_)); for (int i = blockIdx.x * 512 + t_; i < n; i += gridDim.x * 512) p[i] = 0.f; }

__device__ __forceinline__ void ph_inproj(const Params& P, int l, int sl, LAS unsigned char* lds) {
    inproj_setup(P, l, lds);
    pg8::Gemm g{(const bf16_t*)(P.ws + WS_XB), (const bf16_t*)(P.ws + WS_WIN + l * WIN_L), MS, PN, D, D, 1, sl};
    pg8::StaticOrder S; S.init(MS, PN - 3 * 256, gridDim.x, blockIdx.x);
    EpiInProj E{(const float*)(P.ws + WS_SSQM), (const float*)(P.ws + WS_LB) + l * 512, P.in[5] + l * 256, (const float*)(P.ws + WS_ROPE), (bf16_t*)(P.ws + WS_PROJ), sl, lds, (float*)(P.ws + WS_DEC)};
    pg8::gemm_phase<EpiInProj, pg8::StaticOrder>(lds, g, S, E);
}
__device__ __forceinline__ void ph_branch(const Params& P, int l, int sl, LAS unsigned char* lds) {
    bf16_t* pb = (bf16_t*)(P.ws + WS_PROJ);
    pg8::Gemm g{(const bf16_t*)(P.ws + WS_O), (const bf16_t*)(P.ws + WS_WBR + l * WBR_L), MS, D, 1536, 1536, 0, 0};
    pg8::StaticOrder S; S.init(MS, D, gridDim.x, blockIdx.x);
    EpiGate E{(const unsigned char*)(pb + PO_MG), (bf16_t*)((unsigned char*)P.out + DO_GP)};
    pg8::gemm_phase<EpiGate, pg8::StaticOrder>(lds, g, S, E);
    (void)sl;
}
__device__ __forceinline__ void ph_outproj(const Params& P, int l, int sl, LAS unsigned char* lds) {
    const bf16_t* pb = (const bf16_t*)(P.ws + WS_PROJ);
    pg8::Gemm g{(const bf16_t*)((const unsigned char*)P.out + DO_GP), (const bf16_t*)(P.ws + WS_WOUT + l * WOUT_L), MS, D, D, D, 0, 0};
    pg8::StaticOrder S; S.init(MS, D, gridDim.x, blockIdx.x);
    EpiResid E{(bf16_t*)(P.ws + WS_XB), (float*)(P.ws + WS_SSQF), sl};
    pg8::gemm_phase<EpiResid, pg8::StaticOrder>(lds, g, S, E);
}
__device__ __forceinline__ void ph_ffn1(const Params& P, int l, int sl, LAS unsigned char* lds) {
    if (tid_() == 0) *(LAS int*)(lds + RSTD_OFF + 1024) = -1;
    __syncthreads();
    bf16_t* pb = (bf16_t*)(P.ws + WS_PROJ);
    pg8::Gemm g{(const bf16_t*)(P.ws + WS_XB), (const bf16_t*)(P.ws + WS_WGU + l * WGU_L), MS, GU, D, D, 1, sl};
    pg8::StaticOrder S; S.init(MS, GU, gridDim.x, blockIdx.x);
    EpiSwiGLU E{(const float*)(P.ws + WS_SSQF), (bf16_t*)((unsigned char*)P.out + DO_ACT), sl, lds};
    pg8::gemm_phase<EpiSwiGLU, pg8::StaticOrder>(lds, g, S, E);
}
__device__ __forceinline__ void ph_ffn2(const Params& P, int l, int sl, LAS unsigned char* lds) {
    const bf16_t* pb = (const bf16_t*)(P.ws + WS_PROJ);
    pg8::Gemm g{(const bf16_t*)((const unsigned char*)P.out + DO_ACT), (const bf16_t*)(P.ws + WS_WDN + l * WDN_L), MS, D, FF, FF, 0, 0};
    pg8::StaticOrder S; S.init(MS, D, gridDim.x, blockIdx.x);
    EpiResid E{(bf16_t*)(P.ws + WS_XB), (float*)(P.ws + WS_SSQM), sl};
    pg8::gemm_phase<EpiResid, pg8::StaticOrder>(lds, g, S, E);
}

__global__ void __launch_bounds__(512, 2) mega_fwd(Params P) {
    extern __shared__ __attribute__((aligned(16))) unsigned char lds_raw[];
    LAS unsigned char* lds = (LAS unsigned char*)lds_raw;
    volatile LAS unsigned* MISC = (volatile LAS unsigned*)(lds + MISC_OFF);
    { const int t0 = threadIdx.x;
        if ((t0 & 63) == 0) *(volatile LAS int*)(unsigned long)(WAVTAB_OFF + 4 * hw_slot_()) = t0 >> 6;
        if (t0 < 32) MISC[t0] = 0u; }
    __syncthreads();
    const int lo = P.ph_lo, hi = P.ph_hi;
    const bool multi = (hi - lo) > 1;
    XcdBarrier bar; bar.bar = (unsigned*)(P.ws + WS_CTL) + CW_BAR; bar.x = 0; bar.st = MISC + 8;
    if (multi) bar = xcd_barrier_post((unsigned*)(P.ws + WS_CTL) + CW_BAR, MISC + 8);
#ifndef PH_MASK
#define PH_MASK 0xFF
#endif
#define PHM(n) (((PH_MASK) >> (n)) & 1)
#define IN(k) (lo <= (k) && (k) < hi)
#define SEAM(k) do { if (IN((k) + 1)) { xcd_barrier(bar); } } while (0)
    if (PHM(0) && IN(0)) { ph_prologue(P, lds); __syncthreads(); SEAM(0); }
    for (int lh = 0; lh < DEPTH * NSL; ++lh) {
        const int l = lh / NSL, sl = lh % NSL, pb = 1 + 6 * lh;
        if (PHM(1) && IN(pb + 0)) { ph_inproj(P, l, sl, lds); SEAM(pb + 0); }
        if (PHM(2) && IN(pb + 1)) { ph_scan(P, l, sl, lds); __syncthreads(); __syncthreads(); SEAM(pb + 1); }
        if (PHM(3) && IN(pb + 2)) { ph_branch(P, l, sl, lds); SEAM(pb + 2); }
        if (PHM(4) && IN(pb + 3)) { ph_outproj(P, l, sl, lds); SEAM(pb + 3); }
        if (PHM(5) && IN(pb + 4)) { ph_ffn1(P, l, sl, lds); SEAM(pb + 4); }
        if (PHM(6) && IN(pb + 5)) { ph_ffn2(P, l, sl, lds); if (lh == DEPTH * NSL - 1) SEAM(pb + 5); else __syncthreads(); }
    }
    if (PHM(7) && IN(NPH - 1)) ph_final(P);
#undef IN
#undef SEAM
}

extern "C" void kernel_launch(void* const* d_in, const int* in_sizes, int n_in, void* d_out, int out_size, void* d_ws, size_t ws_size, hipStream_t stream) {
    static int grid = 0;
    if (grid == 0) {
        if (n_in != 17 || in_sizes[0] != M * D || out_size != M * D || ws_size < WS_END) { fprintf(stderr, "kernel_launch: unexpected shapes (n_in %d, in0 %d, out %d, ws %zu); nothing launched\n", n_in, n_in > 0 ? in_sizes[0] : -1, out_size, ws_size); grid = -1; return; }
        int dev = 0, cus = 0, per_cu = 0;
        if (hipGetDevice(&dev) != hipSuccess || hipDeviceGetAttribute(&cus, hipDeviceAttributeMultiprocessorCount, dev) != hipSuccess) { grid = -1; return; }
        if (hipFuncSetAttribute((const void*)mega_fwd, hipFuncAttributeMaxDynamicSharedMemorySize, LDS_BYTES) != hipSuccess) { fprintf(stderr, "kernel_launch: hipFuncSetAttribute failed\n"); grid = -1; return; }
        if (hipOccupancyMaxActiveBlocksPerMultiprocessor(&per_cu, (const void*)mega_fwd, 512, LDS_BYTES) != hipSuccess || per_cu < 1) { fprintf(stderr, "kernel_launch: occupancy query says %d\n", per_cu); }
        (void)hipGetLastError();
        grid = cus;
    }
    if (grid < 0) return;
    if (hipMemsetAsync((char*)d_ws + WS_CTL, 0, CTL_ZERO_BYTES, stream) != hipSuccess) return;
    Params p{};
    for (int i = 0; i < 17; ++i) p.in[i] = (const float*)d_in[i];
    p.out = (float*)d_out; p.ws = (unsigned char*)d_ws;
#if MK_N_LAUNCHES == 1
    p.ph_lo = 0; p.ph_hi = NPH;
    hipLaunchKernelGGL(mega_fwd, dim3(grid), dim3(512), LDS_BYTES, stream, p);
#else
    for (int k = 0; k < NPH; ++k) { p.ph_lo = k; p.ph_hi = k + 1; hipLaunchKernelGGL(mega_fwd, dim3(grid), dim3(512), LDS_BYTES, stream, p); }
#endif
}
```
